# Optimizing an MI355X kernel written in HIP

```python
import math
import jax, jax.numpy as jnp
from jax import lax
import numpy as np


D_MODEL = 1024
BATCH = 4
SEQ = 8192
DEPTH = 1

D_MIX = D_MODEL
HYENA_WIDTH = D_MIX // 2
POOL_WIDTH = D_MIX - HYENA_WIDTH
HYENA_ORDER = 2
N_DIRECTIONS = 2
SHORT_CONV = 3
FILTER_EMB = 33
FILTER_BANDS = (FILTER_EMB - 1) // 2
FILTER_HIDDEN = 64
FAST_DECAY_PCT = 0.3
SLOW_DECAY_PCT = 1.5
DECAY_TARGET = 1e-2
POOL_WINDOWS = (2, 4, 8, 16)
POOL_GROUP = POOL_WIDTH // len(POOL_WINDOWS)
HYENA_IN = (HYENA_ORDER + 1) * HYENA_WIDTH
PROJ_WIDTH = HYENA_IN + HYENA_WIDTH + 2 * POOL_WIDTH
EPS = 1e-6

kernel_name = 'hyena_pool_hybrid_block'


def rms_norm(x, g):
    xf = x.astype(jnp.float32)
    y = xf * lax.rsqrt(jnp.mean(xf * xf, axis=-1, keepdims=True) + EPS)
    return (y * g.astype(jnp.float32)).astype(x.dtype)


def short_conv(u, w, b):
    L = u.shape[1]
    up = jnp.pad(u, ((0, 0), (1, 1), (0, 0)))
    return up[:, :L] * w[0] + up[:, 1:L + 1] * w[1] + up[:, 2:] * w[2] + b


def hyena_filters(L, w1, b1, w2, b2, w3, b3, freq, w_proj):
    f32 = jnp.float32
    w1, b1, w2, b2, w3, b3, freq, w_proj = [a.astype(f32) for a in (w1, b1, w2, b2, w3, b3, freq, w_proj)]
    t = jnp.linspace(0.0, 1.0, L, dtype=f32)[:, None]
    pos = jnp.arange(L, dtype=f32)[:, None]
    ang = 2.0 * math.pi * pos / L
    bands = jnp.linspace(1e-4, FILTER_BANDS - 1, FILTER_BANDS, dtype=f32)[None, :]
    z = jnp.concatenate([t, jnp.cos(bands * ang), -jnp.sin(bands * ang)], axis=-1)
    h = jnp.sin(freq * (z @ w1 + b1))
    h = jnp.sin(freq * (h @ w2 + b2))
    h = jnp.sin(freq * (h @ w3 + b3))
    h = (h @ w_proj).reshape(L, HYENA_ORDER, N_DIRECTIONS, HYENA_WIDTH)
    max_decay = math.log(DECAY_TARGET) / FAST_DECAY_PCT
    min_decay = math.log(DECAY_TARGET) / SLOW_DECAY_PCT
    deltas = jnp.linspace(min_decay, max_decay, HYENA_WIDTH, dtype=f32)
    decay = jnp.exp(-t * jnp.abs(deltas)[None, :])
    return h * decay[:, None, None, :]


def two_sided_spectrum(h):
    L = h.shape[0]
    k_fwd = h[:, :, 0]
    k_bwd = h[:, :, 1]
    k_full = jnp.concatenate([k_fwd, jnp.zeros_like(k_fwd[:1]), k_bwd[:0:-1]], axis=0)
    return jnp.fft.rfft(k_full, n=2 * L, axis=0)


def fft_conv(u, k_f, d):
    L = u.shape[1]
    uf = u.astype(jnp.float32)
    u_f = jnp.fft.rfft(uf, n=2 * L, axis=1)
    y = jnp.fft.irfft(u_f * k_f[None], n=2 * L, axis=1)[:, :L]
    return (y + uf * d.astype(jnp.float32)).astype(u.dtype)


def multiscale_pool(u, pool_w, pool_scale):
    B, L, C = u.shape
    uf = u.astype(jnp.float32)
    S = jnp.concatenate([jnp.zeros((B, 1, C), jnp.float32), jnp.cumsum(uf, axis=1)], axis=1)
    pos = jnp.arange(L)
    outs = []
    for g, w in enumerate(POOL_WINDOWS):
        sl = slice(g * POOL_GROUP, (g + 1) * POOL_GROUP)
        lo = jnp.clip(pos - w // 2, 0, L - 1)
        hi = jnp.clip(pos + (w - 1 - w // 2), 0, L - 1)
        total = jnp.take(S[..., sl], hi + 1, axis=1) - jnp.take(S[..., sl], lo, axis=1)
        cnt = (hi - lo + 1).astype(jnp.float32)[None, :, None]
        pooled = total / cnt - uf[..., sl]
        outs.append(jnp.einsum('blc,cd->bld', pooled, pool_w[g].astype(jnp.float32)))
    y = jnp.concatenate(outs, axis=-1) * pool_scale.astype(jnp.float32)
    return y.astype(u.dtype)


def hybrid_layer(x, pre_g, w_in, conv_w, conv_b, fw1, fb1, fw2, fb2, fw3, fb3, ffreq, fw_out,
                 hyena_d, pool_w, pool_scale, norm_h_g, norm_p_g, w_out, post_g):
    L = x.shape[1]
    h = rms_norm(x, pre_g)
    p = jnp.einsum('bld,dk->blk', h, w_in)
    hy = short_conv(p[..., :HYENA_IN], conv_w, conv_b)
    v = hy[..., :HYENA_WIDTH]
    gates = (hy[..., HYENA_WIDTH:2 * HYENA_WIDTH], hy[..., 2 * HYENA_WIDTH:])
    z_h = p[..., HYENA_IN:HYENA_IN + HYENA_WIDTH]
    u_p = p[..., HYENA_IN + HYENA_WIDTH:HYENA_IN + HYENA_WIDTH + POOL_WIDTH]
    z_p = p[..., HYENA_IN + HYENA_WIDTH + POOL_WIDTH:]
    k_f = two_sided_spectrum(hyena_filters(L, fw1, fb1, fw2, fb2, fw3, fb3, ffreq, fw_out))
    y = v
    for o in range(HYENA_ORDER):
        y = gates[o] * fft_conv(y, k_f[:, o], hyena_d[o])
    y_h = rms_norm(y * jax.nn.silu(z_h), norm_h_g)
    y_p = rms_norm(multiscale_pool(u_p, pool_w, pool_scale) * jax.nn.silu(z_p), norm_p_g)
    out = jnp.einsum('blk,kd->bld', jnp.concatenate([y_h, y_p], axis=-1), w_out)
    return x + rms_norm(out, post_g)


def setup_inputs(seed: int = 0) -> dict:
    key = jax.random.key(seed)
    ks = jax.random.split(key, 24)

    def nrm(k, shape, scale):
        return jax.random.normal(k, shape, jnp.float32) * scale

    n_filt_out = HYENA_ORDER * N_DIRECTIONS * HYENA_WIDTH
    return {
        'x': nrm(ks[0], (BATCH, SEQ, D_MODEL), 1.0),
        'pre_norm_g': 1.0 + nrm(ks[1], (DEPTH, D_MODEL), 0.02),
        'w_in': nrm(ks[2], (DEPTH, D_MODEL, PROJ_WIDTH), D_MODEL ** -0.5),
        'conv_w': nrm(ks[3], (DEPTH, SHORT_CONV, HYENA_IN), SHORT_CONV ** -0.5),
        'conv_b': nrm(ks[4], (DEPTH, HYENA_IN), 0.01),
        'filt_w1': nrm(ks[5], (DEPTH, FILTER_EMB, FILTER_HIDDEN), FILTER_EMB ** -0.5),
        'filt_b1': nrm(ks[6], (DEPTH, FILTER_HIDDEN), 0.1),
        'filt_w2': nrm(ks[7], (DEPTH, FILTER_HIDDEN, FILTER_HIDDEN), FILTER_HIDDEN ** -0.5),
        'filt_b2': nrm(ks[8], (DEPTH, FILTER_HIDDEN), 0.1),
        'filt_w3': nrm(ks[9], (DEPTH, FILTER_HIDDEN, FILTER_HIDDEN), FILTER_HIDDEN ** -0.5),
        'filt_b3': nrm(ks[10], (DEPTH, FILTER_HIDDEN), 0.1),
        'filt_freq': 1.0 + nrm(ks[11], (DEPTH, FILTER_HIDDEN), 0.02),
        'filt_w_out': nrm(ks[12], (DEPTH, FILTER_HIDDEN, n_filt_out), 0.5 * FILTER_HIDDEN ** -0.5),
        'hyena_d': nrm(ks[13], (DEPTH, HYENA_ORDER, HYENA_WIDTH), 0.5),
        'pool_w': nrm(ks[14], (DEPTH, len(POOL_WINDOWS), POOL_GROUP, POOL_GROUP), POOL_GROUP ** -0.5),
        'pool_scale': 1.0 + nrm(ks[15], (DEPTH, POOL_WIDTH), 0.02),
        'norm_h_g': 1.0 + nrm(ks[16], (DEPTH, HYENA_WIDTH), 0.02),
        'norm_p_g': 1.0 + nrm(ks[17], (DEPTH, POOL_WIDTH), 0.02),
        'w_out': nrm(ks[18], (DEPTH, D_MIX, D_MODEL), D_MIX ** -0.5),
        'post_norm_g': 1.0 + nrm(ks[19], (DEPTH, D_MODEL), 0.02),
    }


def reference(x, pre_norm_g, w_in, conv_w, conv_b, filt_w1, filt_b1, filt_w2, filt_b2, filt_w3, filt_b3,
              filt_freq, filt_w_out, hyena_d, pool_w, pool_scale, norm_h_g, norm_p_g, w_out, post_norm_g):
    for i in range(DEPTH):
        x = hybrid_layer(x, pre_norm_g[i], w_in[i], conv_w[i], conv_b[i],
                         filt_w1[i], filt_b1[i], filt_w2[i], filt_b2[i], filt_w3[i], filt_b3[i],
                         filt_freq[i], filt_w_out[i], hyena_d[i], pool_w[i], pool_scale[i],
                         norm_h_g[i], norm_p_g[i], w_out[i], post_norm_g[i])
    return x
```

```cpp
#include <hip/hip_runtime.h>
#include <hip/hip_cooperative_groups.h>
#include <cstdio>
namespace cg = cooperative_groups;
namespace pg8 {
#define PG8_LAS __attribute__((address_space(3)))
typedef unsigned short bf16_t;
typedef short bf16x8 __attribute__((ext_vector_type(8)));
typedef float f32x4 __attribute__((ext_vector_type(4)));
typedef unsigned u32x4 __attribute__((ext_vector_type(4)));
constexpr int BM = 256, BK = 64, HALF = 128, HTB = HALF * BK * 2  , STAGE_BYTES = 8 * HTB, NXCD = 8, WGM = 8;

__host__ __device__ __forceinline__ int lds_byte(int r, int c) { const int st = (r >> 4) * 2 + (c >> 5), rr = r & 15, cc = c & 31, ob = rr * 64 + cc * 2; return st * 1024 + (ob ^ (((ob >> 9) & 1) << 5)); }
__host__ __device__ __forceinline__ void stage_rc(int b, int& R, int& C) { const int st = b / 1024, sb = b % 1024, swz = sb ^ (((sb >> 9) & 1) << 5); R = (st >> 1) * 16 + swz / 64; C = (st & 1) * 32 + (swz % 64) / 2; }
__host__ __device__ __forceinline__ int perm32(int rho) { const int n = rho >> 4, i = rho & 15; return 8 * (i >> 2) + 4 * n + (i & 3); }
struct Unit { int pm, pn; };
struct Gemm { const bf16_t* A; const bf16_t* Bt; int M, N, K; };

struct StaticOrder {
    int nM, nN, nwg, G, c;
    __host__ __device__ void init(int M, int N, int G_, int c_) { nM = M / BM; nN = N / BM; nwg = nM * nN; G = G_; c = c_; }
    __host__ __device__ bool next(int i, Unit& u) const {
        const long L = (long)i * G + c; if (L >= nwg) return false;
        int wgid = (int)L; { const int q = nwg / NXCD, r = nwg % NXCD, xcd = wgid % NXCD, off = wgid / NXCD; wgid = (xcd < r ? xcd * (q + 1) : r * (q + 1) + (xcd - r) * q) + off; }
        const int nig = WGM * nN, gid = wgid / nig, fm = gid * WGM, gsz = (nM - fm) < WGM ? (nM - fm) : WGM;
        u.pm = fm + ((wgid % nig) % gsz); u.pn = (wgid % nig) / gsz; return true;
    }
    __device__ __forceinline__ void a_ready(const Unit&) const {}
    __device__ __forceinline__ void done(const Unit&) const {}
};
__device__ __forceinline__ unsigned cvt_pk_bf16(float lo, float hi) { unsigned r; asm volatile("v_cvt_pk_bf16_f32 %0, %1, %2" : "=v"(r) : "v"(lo), "v"(hi)); return r; }
typedef float f32x2 __attribute__((ext_vector_type(2)));
__device__ __forceinline__ f32x2 gelu_pk(f32x2 v) {
    const f32x2 av = __builtin_elementwise_abs(v), d = av * 0.2316418882f + 1.0f;
    f32x2 t; t.x = __builtin_amdgcn_rcpf(d.x); t.y = __builtin_amdgcn_rcpf(d.y);
    f32x2 q = t * 0.5307027145f + (-0.7265760135f); q = q * t + 0.7107068705f; q = q * t + (-0.142248368f); q = q * t + 0.127414796f; q = q * t;
    const f32x2 s = (v * v) * (-0.72134752044f);
    f32x2 e; e.x = __builtin_amdgcn_exp2f(s.x); e.y = __builtin_amdgcn_exp2f(s.y);
    const f32x2 m = v * (q * e), r = v - m;
    f32x2 o; o.x = v.x < 0.f ? m.x : r.x; o.y = v.y < 0.f ? m.y : r.y; return o;
}

struct EpiF32 {
    static constexpr bool PERM = false, AFTER_DRAIN = false;
    float* C; int ldc; const float* bias;
    __device__ __forceinline__ void operator()(const f32x4 (&acc)[2][2][4][2], const Unit& u, int wr, int wc, int fr, int fq) const {
        const int row0 = u.pm * BM + wr * 64 + fr, col0 = u.pn * BM + wc * 32 + 4 * fq;
        f32x4 bv[2][2];
#pragma unroll
        for (int bj = 0; bj < 2; ++bj)
#pragma unroll
            for (int n = 0; n < 2; ++n) bv[bj][n] = bias ? *(const f32x4*)(bias + col0 + bj * HALF + n * 16) : (f32x4){0.f, 0.f, 0.f, 0.f};
#pragma unroll
        for (int ai = 0; ai < 2; ++ai)
#pragma unroll
            for (int m = 0; m < 4; ++m) { float* rowp = C + (size_t)(row0 + ai * HALF + m * 16) * ldc + col0;
#pragma unroll
                for (int bj = 0; bj < 2; ++bj)
#pragma unroll
                    for (int n = 0; n < 2; ++n) *(f32x4*)(rowp + bj * HALF + n * 16) = acc[ai][bj][m][n] + bv[bj][n]; }
    }
};
template <int ACT  > struct EpiBf16 {
    static constexpr bool PERM = true, AFTER_DRAIN = false;
    bf16_t* O; int ldc; const float* bias; int split_cols; size_t split_stride;
    __device__ __forceinline__ void operator()(const f32x4 (&acc)[2][2][4][2], const Unit& u, int wr, int wc, int fr, int fq) const {
        const int row0 = u.pm * BM + wr * 64 + fr; int colt = u.pn * BM; bf16_t* base = O;
        if (split_cols) { const int t = colt / split_cols; base += (size_t)t * split_stride; colt -= t * split_cols; }
        const int col0 = colt + wc * 32 + 8 * fq, bcol0 = u.pn * BM + wc * 32 + 8 * fq;
        f32x4 bv[2][2];
#pragma unroll
        for (int bj = 0; bj < 2; ++bj)
#pragma unroll
            for (int n = 0; n < 2; ++n) bv[bj][n] = bias ? *(const f32x4*)(bias + bcol0 + bj * HALF + 4 * n) : (f32x4){0.f, 0.f, 0.f, 0.f};
#pragma unroll
        for (int ai = 0; ai < 2; ++ai)
#pragma unroll
            for (int m = 0; m < 4; ++m) { bf16_t* rowp = base + (size_t)(row0 + ai * HALF + m * 16) * ldc + col0;
#pragma unroll
                for (int bj = 0; bj < 2; ++bj) { f32x4 v0 = acc[ai][bj][m][0] + bv[bj][0], v1 = acc[ai][bj][m][1] + bv[bj][1];
                    if (ACT == 1) { f32x2 a = gelu_pk((f32x2){v0[0], v0[1]}), b = gelu_pk((f32x2){v0[2], v0[3]}), c = gelu_pk((f32x2){v1[0], v1[1]}), d = gelu_pk((f32x2){v1[2], v1[3]});
                        v0 = (f32x4){a.x, a.y, b.x, b.y}; v1 = (f32x4){c.x, c.y, d.x, d.y}; }
                    if (ACT == 2) {
#pragma unroll
                        for (int j = 0; j < 4; ++j) { v0[j] = 0.5f * v0[j] * (1.0f + erff(v0[j] * 0.70710678f)); v1[j] = 0.5f * v1[j] * (1.0f + erff(v1[j] * 0.70710678f)); } }
                    u32x4 w; w.x = cvt_pk_bf16(v0[0], v0[1]); w.y = cvt_pk_bf16(v0[2], v0[3]); w.z = cvt_pk_bf16(v1[0], v1[1]); w.w = cvt_pk_bf16(v1[2], v1[3]);
                    *(u32x4*)(rowp + bj * HALF) = w; } }
    }
};

template <class Epi, class Sched, bool STAMP = false>
__device__ __forceinline__ void gemm_phase(PG8_LAS unsigned char* lds, const Gemm g, const Sched& S, const Epi& E, unsigned long long* stamps) {
    const int tid = threadIdx.x, wid = __builtin_amdgcn_readfirstlane(tid >> 6), lane = tid & 63, wr = wid >> 2, wc = wid & 3, fr = lane & 15, fq = lane >> 4;
    const int K = g.K, nt = K / BK;
    int ts_lo = 0, ts_hi = 0, nts = 0; const unsigned long long rt_entry = STAMP ? (unsigned long long)wall_clock64() : 0ull;
#define PG8_STAMP() do { if (STAMP && wid == 0 && nts < 64) { const unsigned long long _c = (unsigned long long)clock64(); \
        ts_lo = (lane == nts) ? (int)(unsigned)_c : ts_lo; ts_hi = (lane == nts) ? (int)(unsigned)(_c >> 32) : ts_hi; ++nts; } } while (0)
    PG8_STAMP();
    unsigned voffA[2], voffB[2];
#pragma unroll
    for (int i = 0; i < 2; ++i) { int R, C; stage_rc(tid * 16 + i * 8192, R, C); const int Rb = Epi::PERM ? ((R & ~31) + perm32(R & 31)) : R;
        voffA[i] = (unsigned)(R * K + C) * 2u; voffB[i] = (unsigned)(Rb * K + C) * 2u; }
    const size_t kstep = (size_t)(BK * 2);
    const size_t hstep = (size_t)HALF * K * 2;
    const size_t tstep = 2 * hstep;
    const unsigned ldsw = (unsigned)wid * 1024u;
    const int aoff = lds_byte(wr * 64 + fr, fq * 8), boff = lds_byte(wc * 32 + fr, fq * 8);
#define PG8_SA(b, h) (((b) * 2 + (h)) * HTB)
#define PG8_SB(b, h) ((4 + (b) * 2 + (h)) * HTB)
#define PG8_STAGE(bufoff, gbase, voff) do { _Pragma("unroll") for (int _i = 0; _i < 2; ++_i) \
        __builtin_amdgcn_global_load_lds((const unsigned*)((const char*)(gbase) + (voff)[_i]), (PG8_LAS unsigned*)(lds + (bufoff) + ldsw + _i * 8192), 16, 0, 0); } while (0)
#define PG8_LDA(dst, b, h) do { _Pragma("unroll") for (int m = 0; m < 4; ++m) _Pragma("unroll") for (int k = 0; k < 2; ++k) dst[m][k] = *(const PG8_LAS bf16x8*)(lds + PG8_SA(b, h) + aoff + m * 2048 + k * 1024); } while (0)
#define PG8_LDB(dst, b, h) do { _Pragma("unroll") for (int n = 0; n < 2; ++n) _Pragma("unroll") for (int k = 0; k < 2; ++k) dst[n][k] = *(const PG8_LAS bf16x8*)(lds + PG8_SB(b, h) + boff + n * 2048 + k * 1024); } while (0)
#define PG8_MMA(ai, bj, At, Bt) do { __builtin_amdgcn_s_setprio(1); _Pragma("unroll") for (int m = 0; m < 4; ++m) _Pragma("unroll") for (int n = 0; n < 2; ++n) _Pragma("unroll") for (int k = 0; k < 2; ++k) \
        acc[ai][bj][m][n] = __builtin_amdgcn_mfma_f32_16x16x32_bf16(Bt[n][k], At[m][k], acc[ai][bj][m][n], 0, 0, 0); __builtin_amdgcn_s_setprio(0); } while (0)
#define PG8_WAIT_V(n) asm volatile("s_waitcnt vmcnt(" #n ")" ::: "memory")
#define PG8_WAIT_L(n) asm volatile("s_waitcnt lgkmcnt(" #n ")" ::: "memory")
#define PG8_BAR __builtin_amdgcn_s_barrier()
#define PG8_SCHED __builtin_amdgcn_sched_barrier(0)
    Unit cur, nxt; int ui = 0;
    if (!S.next(0, cur)) return;
    f32x4 acc[2][2][4][2];
#pragma unroll
    for (int a = 0; a < 2; ++a)
#pragma unroll
        for (int b = 0; b < 2; ++b)
#pragma unroll
            for (int m = 0; m < 4; ++m)
#pragma unroll
                for (int n = 0; n < 2; ++n) acc[a][b][m][n] = (f32x4){0.f, 0.f, 0.f, 0.f};
    bf16x8 At[4][2], B0[2][2], B1[2][2];
    const char* cA = (const char*)g.A + (size_t)cur.pm * tstep; const char* cB = (const char*)g.Bt + (size_t)cur.pn * tstep;
    S.a_ready(cur);
    PG8_STAGE(PG8_SB(0, 0), cB, voffB); PG8_STAGE(PG8_SA(0, 0), cA, voffA); PG8_STAGE(PG8_SB(0, 1), cB + hstep, voffB); PG8_STAGE(PG8_SA(0, 1), cA + hstep, voffA);
    if (wr == 1) PG8_BAR;
    PG8_WAIT_V(4); PG8_BAR;
    PG8_STAGE(PG8_SB(1, 0), cB + kstep, voffB); PG8_STAGE(PG8_SA(1, 0), cA + kstep, voffA); PG8_STAGE(PG8_SB(1, 1), cB + hstep + kstep, voffB);
    PG8_WAIT_V(6); PG8_BAR;
    PG8_STAMP();
    for (;;) {
        const bool has_next = S.next(ui + 1, nxt);
        const char* nA = has_next ? (const char*)g.A + (size_t)nxt.pm * tstep : cA; const char* nB = has_next ? (const char*)g.Bt + (size_t)nxt.pn * tstep : cB;
        for (int t = 0; t < nt; t += 2) {
            const bool last = (t == nt - 2);
            const char* a1 = cA + (size_t)(t + 1) * kstep;
            const char* a2 = last ? nA : cA + (size_t)(t + 2) * kstep; const char* b2 = last ? nB : cB + (size_t)(t + 2) * kstep;
            const char* a3 = a2 + kstep; const char* b3 = b2 + kstep;
            if (last && has_next) S.a_ready(nxt);
            PG8_LDB(B0, 0, 0); PG8_SCHED; PG8_LDA(At, 0, 0); PG8_STAGE(PG8_SA(1, 1), a1 + hstep, voffA);
            PG8_WAIT_L(8); PG8_BAR; PG8_WAIT_L(0); PG8_MMA(0, 0, At, B0); PG8_BAR; PG8_SCHED;
            PG8_LDB(B1, 0, 1); PG8_STAGE(PG8_SB(0, 0), b2, voffB);
            PG8_BAR; PG8_WAIT_L(0); PG8_MMA(0, 1, At, B1); PG8_BAR;
            PG8_LDA(At, 0, 1); PG8_STAGE(PG8_SA(0, 0), a2, voffA);
            PG8_BAR; PG8_WAIT_L(0); PG8_MMA(1, 0, At, B0); PG8_BAR; PG8_SCHED;
            PG8_STAGE(PG8_SB(0, 1), b2 + hstep, voffB);
            PG8_WAIT_V(6); PG8_BAR; PG8_MMA(1, 1, At, B1); PG8_BAR;
            PG8_LDB(B0, 1, 0); PG8_SCHED; PG8_LDA(At, 1, 0); PG8_STAGE(PG8_SA(0, 1), a2 + hstep, voffA);
            PG8_WAIT_L(8); PG8_BAR; PG8_WAIT_L(0); PG8_MMA(0, 0, At, B0); PG8_BAR; PG8_SCHED;
            PG8_LDB(B1, 1, 1); PG8_STAGE(PG8_SB(1, 0), b3, voffB);
            PG8_BAR; PG8_WAIT_L(0); PG8_MMA(0, 1, At, B1); PG8_BAR;
            PG8_LDA(At, 1, 1); PG8_STAGE(PG8_SA(1, 0), a3, voffA);
            PG8_BAR; PG8_WAIT_L(0); PG8_MMA(1, 0, At, B0); PG8_BAR; PG8_SCHED;
            PG8_STAGE(PG8_SB(1, 1), b3 + hstep, voffB);
            PG8_WAIT_V(6); PG8_BAR; PG8_MMA(1, 1, At, B1); PG8_BAR;
        }
        PG8_STAMP();
        if constexpr (!Epi::AFTER_DRAIN) { E(acc, cur, wr, wc, fr, fq); S.done(cur); }
        PG8_STAMP();
        if (!has_next) break;
#pragma unroll
        for (int a = 0; a < 2; ++a)
#pragma unroll
            for (int b = 0; b < 2; ++b)
#pragma unroll
                for (int m = 0; m < 4; ++m)
#pragma unroll
                    for (int n = 0; n < 2; ++n) acc[a][b][m][n] = (f32x4){0.f, 0.f, 0.f, 0.f};
        cur = nxt; cA = nA; cB = nB; ++ui;
    }
    PG8_WAIT_V(0);
    if (wr == 0) PG8_BAR;
    PG8_BAR;
    if constexpr (Epi::AFTER_DRAIN) { E.fused(acc, cur, wr, wc, fr, fq, lds, wid, lane); S.done(cur); }
    PG8_STAMP();
    if (STAMP && wid == 0) { stamps[lane] = lane < nts ? (((unsigned long long)(unsigned)ts_hi << 32) | (unsigned)ts_lo) : 0ull;
        if (lane == 62) stamps[62] = rt_entry; if (lane == 63) stamps[63] = (unsigned long long)wall_clock64(); }
#undef PG8_STAMP
#undef PG8_SA
#undef PG8_SB
#undef PG8_STAGE
#undef PG8_LDA
#undef PG8_LDB
#undef PG8_MMA
#undef PG8_WAIT_V
#undef PG8_WAIT_L
#undef PG8_BAR
#undef PG8_SCHED
}
}
using pg8::bf16_t; using pg8::bf16x8; using pg8::f32x4; using pg8::u32x4; using pg8::cvt_pk_bf16;

constexpr int DM = 1024, NBATCH = 4, SEQ = 8192, NTOK = NBATCH * SEQ, HWD = 512, FN = 16384;
constexpr int NTHREADS = 512;
constexpr size_t MBY = 1024 * 1024;
constexpr size_t WS_XN = 0, WS_PT = 64 * MBY, WS_PR = 192 * MBY, WS_KF = 256 * MBY, WS_Y1 = 320 * MBY, WS_GT = 384 * MBY, WS_W1T = 416 * MBY, WS_W2T = 422 * MBY, WS_PWT = 424 * MBY, WS_KS = 425 * MBY;
constexpr size_t WS_A2 = WS_XN, WS_OUTB = WS_PT;
constexpr int LDS_BYTES = 151552;
constexpr int NPHASE = 6;

struct Params {
    const float* in[20];
    float* out;
    unsigned char* ws;
    int phase_lo, phase_hi;
};

__device__ __forceinline__ float bf2f(bf16_t v) { return __uint_as_float((unsigned)v << 16); }
__device__ __forceinline__ bf16_t f2bf(float v) { return (bf16_t)(cvt_pk_bf16(v, 0.f) & 0xffffu); }
__device__ __forceinline__ float wave_sum(float v) {
#pragma unroll
    for (int o = 32; o; o >>= 1) v += __shfl_xor(v, o);
    return v;
}
__device__ __forceinline__ float silu(float z) { return z / (1.0f + __expf(-z)); }

__device__ __forceinline__ void ph_rmsnorm_in(const float* __restrict__ x, bf16_t* __restrict__ xn) {
    const int lane = threadIdx.x & 63, wid = threadIdx.x >> 6;
    for (int row = blockIdx.x * 8 + wid; row < NTOK; row += gridDim.x * 8) {
        const float4* xr = (const float4*)(x + (size_t)row * DM);
        const float4 a0 = xr[lane * 2], a1 = xr[lane * 2 + 1], b0 = xr[128 + lane * 2], b1 = xr[129 + lane * 2];
        float ss = a0.x * a0.x + a0.y * a0.y + a0.z * a0.z + a0.w * a0.w + a1.x * a1.x + a1.y * a1.y + a1.z * a1.z + a1.w * a1.w
                 + b0.x * b0.x + b0.y * b0.y + b0.z * b0.z + b0.w * b0.w + b1.x * b1.x + b1.y * b1.y + b1.z * b1.z + b1.w * b1.w;
        ss = wave_sum(ss);
        const float r = rsqrtf(ss * (1.0f / DM) + 1e-6f);
        u32x4 w0, w1;
        w0.x = cvt_pk_bf16(a0.x * r, a0.y * r); w0.y = cvt_pk_bf16(a0.z * r, a0.w * r); w0.z = cvt_pk_bf16(a1.x * r, a1.y * r); w0.w = cvt_pk_bf16(a1.z * r, a1.w * r);
        w1.x = cvt_pk_bf16(b0.x * r, b0.y * r); w1.y = cvt_pk_bf16(b0.z * r, b0.w * r); w1.z = cvt_pk_bf16(b1.x * r, b1.y * r); w1.w = cvt_pk_bf16(b1.z * r, b1.w * r);
        *(u32x4*)(xn + (size_t)row * DM + lane * 8) = w0;
        *(u32x4*)(xn + (size_t)row * DM + 512 + lane * 8) = w1;
    }
}

__device__ __forceinline__ void ph_weights(const Params& p) {
    const int gt = blockIdx.x * NTHREADS + threadIdx.x, gs = gridDim.x * NTHREADS;
    const float* __restrict__ w_in = p.in[2]; const float* __restrict__ g = p.in[1];
    const float* __restrict__ w_out = p.in[18]; const float* __restrict__ pw = p.in[14];
    bf16_t* W1t = (bf16_t*)(p.ws + WS_W1T); bf16_t* W2t = (bf16_t*)(p.ws + WS_W2T); bf16_t* PWt = (bf16_t*)(p.ws + WS_PWT);
    for (int i = gt; i < 128 * 3072; i += gs) {
        const int n = i % 3072, k8 = i / 3072; float v[8];
#pragma unroll
        for (int e = 0; e < 8; ++e) v[e] = w_in[(size_t)(k8 * 8 + e) * 3072 + n] * g[k8 * 8 + e];
        u32x4 w; w.x = cvt_pk_bf16(v[0], v[1]); w.y = cvt_pk_bf16(v[2], v[3]); w.z = cvt_pk_bf16(v[4], v[5]); w.w = cvt_pk_bf16(v[6], v[7]);
        *(u32x4*)(W1t + (size_t)n * 1024 + k8 * 8) = w;
    }
    for (int i = gt; i < 128 * 1024; i += gs) {
        const int n = i & 1023, k8 = i >> 10; float v[8];
#pragma unroll
        for (int e = 0; e < 8; ++e) v[e] = w_out[(size_t)(k8 * 8 + e) * 1024 + n];
        u32x4 w; w.x = cvt_pk_bf16(v[0], v[1]); w.y = cvt_pk_bf16(v[2], v[3]); w.z = cvt_pk_bf16(v[4], v[5]); w.w = cvt_pk_bf16(v[6], v[7]);
        *(u32x4*)(W2t + (size_t)n * 1024 + k8 * 8) = w;
    }
    for (int i = gt; i < 4 * 16 * 128; i += gs) {
        const int d = i & 127, c8 = (i >> 7) & 15, gq = i >> 11; float v[8];
#pragma unroll
        for (int e = 0; e < 8; ++e) v[e] = pw[gq * 16384 + (c8 * 8 + e) * 128 + d];
        u32x4 w; w.x = cvt_pk_bf16(v[0], v[1]); w.y = cvt_pk_bf16(v[2], v[3]); w.z = cvt_pk_bf16(v[4], v[5]); w.w = cvt_pk_bf16(v[6], v[7]);
        *(u32x4*)(PWt + gq * 16384 + d * 128 + c8 * 8) = w;
    }
}

__device__ __forceinline__ void ph_filters(const Params& p, float* smf) {
    float* zs = smf;
    float* ha = smf + 32 * 36;
    float* hb = ha + 32 * 64;
    float* st = hb + 32 * 64;
    const float* __restrict__ w1 = p.in[5]; const float* __restrict__ b1 = p.in[6];
    const float* __restrict__ w2 = p.in[7]; const float* __restrict__ b2 = p.in[8];
    const float* __restrict__ w3 = p.in[9]; const float* __restrict__ b3 = p.in[10];
    const float* __restrict__ fq = p.in[11]; const float* __restrict__ wo = p.in[12];
    float* __restrict__ kf = (float*)(p.ws + WS_KF);
    const int tid = threadIdx.x;
    for (int tile = blockIdx.x; tile < SEQ / 32; tile += gridDim.x) {
        const int l0 = tile * 32;
        __syncthreads();
        for (int i = tid; i < 32 * 33; i += NTHREADS) {
            const int pp = i / 33, f = i % 33, l = l0 + pp; float val;
            if (f == 0) val = (float)l * (1.0f / (float)(SEQ - 1));
            else {
                const int bi = (f - 1) & 15;
                const float band = 1e-4f + (float)bi * ((15.0f - 1e-4f) / 15.0f);
                const float ang = 2.0f * 3.14159265358979323846f * (float)l / (float)SEQ;
                const float a = band * ang;
                val = (f <= 16) ? cosf(a) : -sinf(a);
            }
            zs[pp * 36 + f] = val;
        }
        __syncthreads();
#pragma unroll 1
        for (int i = 0; i < 4; ++i) {
            const int idx = tid + i * NTHREADS, pp = idx >> 6, n = idx & 63;
            float acc = b1[n];
#pragma unroll 3
            for (int f = 0; f < 33; ++f) acc += zs[pp * 36 + f] * w1[f * 64 + n];
            ha[pp * 64 + n] = sinf(fq[n] * acc);
        }
        __syncthreads();
#pragma unroll 1
        for (int i = 0; i < 4; ++i) {
            const int idx = tid + i * NTHREADS, pp = idx >> 6, n = idx & 63;
            float acc = b2[n];
#pragma unroll 4
            for (int f = 0; f < 64; ++f) acc += ha[pp * 64 + f] * w2[f * 64 + n];
            hb[pp * 64 + n] = sinf(fq[n] * acc);
        }
        __syncthreads();
#pragma unroll 1
        for (int i = 0; i < 4; ++i) {
            const int idx = tid + i * NTHREADS, pp = idx >> 6, n = idx & 63;
            float acc = b3[n];
#pragma unroll 4
            for (int f = 0; f < 64; ++f) acc += hb[pp * 64 + f] * w3[f * 64 + n];
            ha[pp * 64 + n] = sinf(fq[n] * acc);
        }
        __syncthreads();
        const float4* wo4 = (const float4*)wo;
#pragma unroll 1
        for (int q = 0; q < 4; ++q) {
            const int cg4 = tid & 127, pg = tid >> 7;
            float acc[8][4];
#pragma unroll
            for (int pp = 0; pp < 8; ++pp) { acc[pp][0] = 0.f; acc[pp][1] = 0.f; acc[pp][2] = 0.f; acc[pp][3] = 0.f; }
#pragma unroll 2
            for (int k = 0; k < 64; k += 4) {
                const float4 q0 = wo4[(k + 0) * 512 + q * 128 + cg4], q1 = wo4[(k + 1) * 512 + q * 128 + cg4], q2 = wo4[(k + 2) * 512 + q * 128 + cg4], q3 = wo4[(k + 3) * 512 + q * 128 + cg4];
#pragma unroll
                for (int pp = 0; pp < 8; ++pp) {
                    const float4 h = *(const float4*)(ha + (pg * 8 + pp) * 64 + k);
                    acc[pp][0] += h.x * q0.x + h.y * q1.x + h.z * q2.x + h.w * q3.x;
                    acc[pp][1] += h.x * q0.y + h.y * q1.y + h.z * q2.y + h.w * q3.y;
                    acc[pp][2] += h.x * q0.z + h.y * q1.z + h.z * q2.z + h.w * q3.z;
                    acc[pp][3] += h.x * q0.w + h.y * q1.w + h.z * q2.w + h.w * q3.w;
                }
            }
            __syncthreads();
#pragma unroll
            for (int pp = 0; pp < 8; ++pp) {
                st[(cg4 * 4 + 0) * 33 + pg * 8 + pp] = acc[pp][0]; st[(cg4 * 4 + 1) * 33 + pg * 8 + pp] = acc[pp][1];
                st[(cg4 * 4 + 2) * 33 + pg * 8 + pp] = acc[pp][2]; st[(cg4 * 4 + 3) * 33 + pg * 8 + pp] = acc[pp][3];
            }
            __syncthreads();
            const int o = q >> 1, dir = q & 1;
            for (int i = tid; i < 512 * 32; i += NTHREADS) {
                const int c = i >> 5, pq = i & 31, pp = dir ? 31 - pq : pq, l = l0 + pp;
                const float adel = 3.070113457325394f + (float)c * ((15.350567286626971f - 3.070113457325394f) / 511.0f);
                const float tt = (float)l * (1.0f / (float)(SEQ - 1));
                float val = st[c * 33 + pp] * expf(-tt * adel);
                int idx = l;
                if (dir) { if (l == 0) { idx = SEQ; val = 0.f; } else idx = 2 * SEQ - l; }
                kf[(size_t)(o * 512 + c) * FN + idx] = val;
            }
        }
    }
}

__device__ __forceinline__ float2 cmulf(float2 a, float2 b) { return make_float2(a.x * b.x - a.y * b.y, a.x * b.y + a.y * b.x); }
__device__ __forceinline__ float2 cmulc(float2 a, float2 b) { return make_float2(a.x * b.x + a.y * b.y, a.y * b.x - a.x * b.y); }
__device__ __forceinline__ constexpr float tw_c(int k) { constexpr float t[16] = {1.000000000f, 0.980785280f, 0.923879533f, 0.831469612f, 0.707106781f, 0.555570233f, 0.382683432f, 0.195090322f, 0.000000000f, -0.195090322f, -0.382683432f, -0.555570233f, -0.707106781f, -0.831469612f, -0.923879533f, -0.980785280f}; return t[k]; }
__device__ __forceinline__ constexpr float tw_s(int k) { constexpr float t[16] = {0.000000000f, 0.195090322f, 0.382683432f, 0.555570233f, 0.707106781f, 0.831469612f, 0.923879533f, 0.980785280f, 1.000000000f, 0.980785280f, 0.923879533f, 0.831469612f, 0.707106781f, 0.555570233f, 0.382683432f, 0.195090322f}; return t[k]; }
__device__ __forceinline__ float2 twf(float2 d, int k) {
    const float s = 0.70710678118f;
    if (k == 0) return d;
    if (k == 8) return make_float2(d.y, -d.x);
    if (k == 4) return make_float2((d.x + d.y) * s, (d.y - d.x) * s);
    if (k == 12) return make_float2((d.y - d.x) * s, -(d.x + d.y) * s);
    const float c = tw_c(k), sn = tw_s(k);
    return make_float2(d.x * c + d.y * sn, d.y * c - d.x * sn);
}
__device__ __forceinline__ float2 twi(float2 d, int k) {
    const float s = 0.70710678118f;
    if (k == 0) return d;
    if (k == 8) return make_float2(-d.y, d.x);
    if (k == 4) return make_float2((d.x - d.y) * s, (d.y + d.x) * s);
    if (k == 12) return make_float2(-(d.x + d.y) * s, (d.x - d.y) * s);
    const float c = tw_c(k), sn = tw_s(k);
    return make_float2(d.x * c - d.y * sn, d.y * c + d.x * sn);
}
__host__ __device__ constexpr int brev(int q, int bits) { int r = 0; for (int i = 0; i < bits; ++i) r |= ((q >> i) & 1) << (bits - 1 - i); return r; }

template <int R, bool ZPAD> __device__ __forceinline__ void dft_dif(float2 (&x)[R]) {
    constexpr int LG = (R == 32) ? 5 : 4;
#pragma unroll
    for (int st = 0; st < LG; ++st) {
        const int h = (R / 2) >> st;
#pragma unroll
        for (int t = 0; t < R / 2; ++t) {
            const int i = t & (h - 1), s = (t >> (LG - 1 - st)) * 2 * h, k = (i * 16) >> (LG - 1 - st);
            const float2 a = x[s + i];
            if (ZPAD && st == 0) { x[s + i + h] = twf(a, k); continue; }
            const float2 b = x[s + i + h];
            x[s + i] = make_float2(a.x + b.x, a.y + b.y);
            x[s + i + h] = twf(make_float2(a.x - b.x, a.y - b.y), k);
        }
    }
}
template <int R> __device__ __forceinline__ void dft_dit(float2 (&x)[R]) {
    constexpr int LG = (R == 32) ? 5 : 4;
#pragma unroll
    for (int st = 0; st < LG; ++st) {
        const int h = 1 << st;
#pragma unroll
        for (int t = 0; t < R / 2; ++t) {
            const int i = t & (h - 1), s = (t >> st) * 2 * h, k = (i * 16) >> st;
            const float2 a = x[s + i], b = twi(x[s + i + h], k);
            x[s + i] = make_float2(a.x + b.x, a.y + b.y);
            x[s + i + h] = make_float2(a.x - b.x, a.y - b.y);
        }
    }
}

template <bool FULL, class LD> __device__ __forceinline__ void fft_f1(float2* sm, LD ld) {
#pragma unroll 1
    for (int jj = 0; jj < 2; ++jj) {
        int j = threadIdx.x + jj * 512; asm volatile("" : "+v"(j));
        float2 x[16];
#pragma unroll
        for (int r = 0; r < 8; ++r) x[r] = ld(j + r * 1024);
#pragma unroll
        for (int r = 8; r < 16; ++r) x[r] = FULL ? ld(j + r * 1024) : make_float2(0.f, 0.f);
        dft_dif<16, !FULL>(x);
        float sn, cs; sincospif((float)j * (1.0f / 8192.0f), &sn, &cs);
        const float2 w1 = make_float2(cs, -sn); float2 w = w1;
        const int base = j + (j >> 5);
        sm[base] = x[0];
#pragma unroll
        for (int q = 1; q < 16; ++q) { sm[base + q * 1056] = cmulf(x[brev(q, 4)], w); w = cmulf(w, w1); }
    }
}
__device__ __forceinline__ void fft_f2(float2* sm) {
    int j = threadIdx.x & 31; asm volatile("" : "+v"(j));
    const int b = threadIdx.x >> 5, base = b * 1056 + j;
    float2 x[32];
#pragma unroll
    for (int r = 0; r < 32; ++r) x[r] = sm[base + r * 33];
    dft_dif<32, false>(x);
    float sn, cs; sincospif((float)j * (1.0f / 512.0f), &sn, &cs);
    const float2 w1 = make_float2(cs, -sn); float2 w = w1;
    sm[base] = x[0];
#pragma unroll
    for (int q = 1; q < 32; ++q) { sm[base + q * 33] = cmulf(x[brev(q, 5)], w); w = cmulf(w, w1); }
}
__device__ __forceinline__ void fft_f3_filter(const float2* sm, float2* __restrict__ K) {
    const int base = threadIdx.x * 33;
    float2 x[32];
#pragma unroll
    for (int r = 0; r < 32; ++r) x[r] = sm[base + r];
    dft_dif<32, false>(x);
#pragma unroll
    for (int r = 0; r < 32; ++r) K[r * 512 + threadIdx.x] = make_float2(x[r].x * (1.0f / (float)FN), x[r].y * (1.0f / (float)FN));
}
__device__ __forceinline__ void fft_f3k(float2* sm, const float2* __restrict__ K) {
    const int base = threadIdx.x * 33;
    float2 x[32];
#pragma unroll
    for (int r = 0; r < 32; ++r) x[r] = sm[base + r];
    dft_dif<32, false>(x);
#pragma unroll
    for (int r = 0; r < 32; ++r) x[r] = cmulf(x[r], K[r * 512 + threadIdx.x]);
    dft_dit<32>(x);
#pragma unroll
    for (int r = 0; r < 32; ++r) sm[base + r] = x[r];
}
__device__ __forceinline__ void fft_i2(float2* sm) {
    int j = threadIdx.x & 31; asm volatile("" : "+v"(j));
    const int b = threadIdx.x >> 5, base = b * 1056 + j;
    float sn, cs; sincospif((float)j * (1.0f / 512.0f), &sn, &cs);
    const float2 w1 = make_float2(cs, -sn); float2 w = w1;
    float2 x[32];
    x[0] = sm[base];
#pragma unroll
    for (int q = 1; q < 32; ++q) { x[brev(q, 5)] = cmulc(sm[base + q * 33], w); w = cmulf(w, w1); }
    dft_dit<32>(x);
#pragma unroll
    for (int r = 0; r < 32; ++r) sm[base + r * 33] = x[r];
}
template <class EP> __device__ __forceinline__ void fft_i1(const float2* sm, EP ep) {
#pragma unroll 1
    for (int jj = 0; jj < 2; ++jj) {
        int j = threadIdx.x + jj * 512; asm volatile("" : "+v"(j));
        float sn, cs; sincospif((float)j * (1.0f / 8192.0f), &sn, &cs);
        const float2 w1 = make_float2(cs, -sn); float2 w = w1;
        const int base = j + (j >> 5);
        float2 x[16];
        x[0] = sm[base];
#pragma unroll
        for (int q = 1; q < 16; ++q) { x[brev(q, 4)] = cmulc(sm[base + q * 1056], w); w = cmulf(w, w1); }
        dft_dit<16>(x);
        float2* smw = const_cast<float2*>(sm);
#pragma unroll
        for (int r = 0; r < 8; ++r) smw[base + r * 1056] = x[r];
#pragma unroll 1
        for (int r = 0; r < 8; ++r) ep(j + r * 1024, smw[base + r * 1056]);
    }
}

__device__ __forceinline__ float sconv(const bf16_t* __restrict__ row, int l, float w0, float w1, float w2, float b) {
    const float a = (l > 0) ? bf2f(row[l - 1]) : 0.f, m = bf2f(row[l]), n = (l < SEQ - 1) ? bf2f(row[l + 1]) : 0.f;
    return a * w0 + m * w1 + n * w2 + b;
}

#define SYNC_SB() do { __syncthreads(); __builtin_amdgcn_sched_barrier(0); } while (0)
__device__ __forceinline__ void ph_fftconv(const Params& p, float2* sm) {
    const bf16_t* pT = (const bf16_t*)(p.ws + WS_PT);
    const float* kf = (const float*)(p.ws + WS_KF);
    float* y1 = (float*)(p.ws + WS_Y1);
    bf16_t* gT = (bf16_t*)(p.ws + WS_GT);
    float2* K = (float2*)(p.ws + WS_KS) + (size_t)blockIdx.x * FN;
    const float* conv_w = p.in[3]; const float* conv_b = p.in[4]; const float* hd = p.in[13];
    for (int c = blockIdx.x; c < HWD; c += gridDim.x) {
        const bf16_t* vrow = pT + (size_t)c * NTOK;
        const bf16_t* zrow = pT + (size_t)(1536 + c) * NTOK;
        float* y1row = y1 + (size_t)c * NTOK;
        bf16_t* grow = gT + (size_t)c * NTOK;
        const float wu0 = conv_w[c], wu1 = conv_w[1536 + c], wu2 = conv_w[3072 + c], bu = conv_b[c];
#pragma unroll 1
        for (int o = 0; o < 2; ++o) {
            const float* kk = kf + (size_t)(o * 512 + c) * FN;
            fft_f1<true>(sm, [&](int i) -> float2 { return make_float2(kk[i], 0.f); });
            SYNC_SB(); fft_f2(sm); SYNC_SB(); fft_f3_filter(sm, K); SYNC_SB();
            const int chg = (o + 1) * 512 + c;
            const float wg0 = conv_w[chg], wg1 = conv_w[1536 + chg], wg2 = conv_w[3072 + chg], bg = conv_b[chg];
            const bf16_t* grw = pT + (size_t)chg * NTOK;
            const float dsk = hd[o * 512 + c];
#pragma unroll 1
            for (int pair = 0; pair < 2; ++pair) {
                const int t0 = pair * 2 * SEQ;
                auto ldu = [&](int l) -> float2 {
                    if (o == 0) return make_float2(sconv(vrow + t0, l, wu0, wu1, wu2, bu), sconv(vrow + t0 + SEQ, l, wu0, wu1, wu2, bu));
                    return make_float2(y1row[t0 + l], y1row[t0 + SEQ + l]);
                };
                fft_f1<false>(sm, ldu);
                SYNC_SB(); fft_f2(sm); SYNC_SB(); fft_f3k(sm, K); SYNC_SB(); fft_i2(sm); SYNC_SB();
                fft_i1(sm, [&](int l, float2 cv) {
                    const float2 u = ldu(l);
                    const float g0 = sconv(grw + t0, l, wg0, wg1, wg2, bg), g1 = sconv(grw + t0 + SEQ, l, wg0, wg1, wg2, bg);
                    const float r0 = g0 * (cv.x + dsk * u.x), r1 = g1 * (cv.y + dsk * u.y);
                    if (o == 0) { y1row[t0 + l] = r0; y1row[t0 + SEQ + l] = r1; }
                    else {
                        const float z0 = bf2f(zrow[t0 + l]), z1 = bf2f(zrow[t0 + SEQ + l]);
                        grow[t0 + l] = f2bf(r0 * silu(z0)); grow[t0 + SEQ + l] = f2bf(r1 * silu(z1));
                    }
                });
            }
        }
    }
}

__device__ __forceinline__ void ph_mix(const Params& p, unsigned char* smem) {
    bf16_t* us = (bf16_t*)smem;
    bf16_t* gs = (bf16_t*)smem;
    bf16_t* pa = (bf16_t*)(smem + 81920);
    float* part = (float*)(smem + 81920 + 66560);
    float* rs = part + 512;
    const bf16_t* gT = (const bf16_t*)(p.ws + WS_GT);
    const bf16_t* pR = (const bf16_t*)(p.ws + WS_PR);
    const bf16_t* PWt = (const bf16_t*)(p.ws + WS_PWT);
    bf16_t* A2 = (bf16_t*)(p.ws + WS_A2);
    const float* pscale = p.in[15]; const float* nhg = p.in[16]; const float* npg = p.in[17];
    const int tid = threadIdx.x, lane = tid & 63, wid = tid >> 6, fr = lane & 15, fq = lane >> 4;
    for (int tile = blockIdx.x; tile < NTOK / 64; tile += gridDim.x) {
        const int tok0 = tile * 64, batch = tok0 / SEQ, l0 = tok0 % SEQ;
        __syncthreads();
        for (int i = tid; i < 4096; i += NTHREADS) {
            const int c = i >> 3, ch = i & 7;
            const u32x4 v = *(const u32x4*)(gT + (size_t)c * NTOK + tok0 + ch * 8);
            unsigned* d = (unsigned*)(gs + c * 66 + ch * 8);
            d[0] = v.x; d[1] = v.y; d[2] = v.z; d[3] = v.w;
        }
        __syncthreads();
        {
            const int tok = tid & 63, cgp = tid >> 6; float s = 0.f;
            for (int cc = 0; cc < 64; ++cc) { const float v = bf2f(gs[(cgp * 64 + cc) * 66 + tok]); s += v * v; }
            part[cgp * 64 + tok] = s;
        }
        __syncthreads();
        if (tid < 64) { float s = 0.f; for (int g = 0; g < 8; ++g) s += part[g * 64 + tid]; rs[tid] = rsqrtf(s * (1.0f / 512.0f) + 1e-6f); }
        __syncthreads();
        for (int tt = 0; tt < 8; ++tt) {
            const int tok = wid * 8 + tt; const float r = rs[tok];
#pragma unroll
            for (int i = 0; i < 8; ++i) { const int c = lane + 64 * i; A2[(size_t)(tok0 + tok) * 1024 + c] = f2bf(bf2f(gs[c * 66 + tok]) * r * nhg[c]); }
        }
        __syncthreads();
        for (int i = tid; i < 80 * 64; i += NTHREADS) {
            const int r = i >> 6, ch = i & 63; int l = l0 - 8 + r; l = l < 0 ? 0 : (l > SEQ - 1 ? SEQ - 1 : l);
            *(u32x4*)(us + r * 512 + ch * 8) = *(const u32x4*)(pR + (size_t)(batch * SEQ + l) * 1024 + ch * 8);
        }
        __syncthreads();
        {
            const int cp = tid & 255, th = tid >> 8, g = cp >> 6, hw = 1 << g;
            for (int tt = 0; tt < 32; ++tt) {
                const int t = th * 32 + tt, l = l0 + t;
                int lo = l - hw; lo = lo < 0 ? 0 : lo; int hi = l + hw - 1; hi = hi > SEQ - 1 ? SEQ - 1 : hi;
                float s0 = 0.f, s1 = 0.f;
                for (int q = lo; q <= hi; ++q) { const unsigned v = *(const unsigned*)(us + (q - l0 + 8) * 512 + 2 * cp); s0 += __uint_as_float(v << 16); s1 += __uint_as_float(v & 0xffff0000u); }
                const unsigned cv = *(const unsigned*)(us + (t + 8) * 512 + 2 * cp);
                const float inv = 1.0f / (float)(hi - lo + 1);
                *(unsigned*)(pa + t * 520 + 2 * cp) = cvt_pk_bf16(s0 * inv - __uint_as_float(cv << 16), s1 * inv - __uint_as_float(cv & 0xffff0000u));
            }
        }
        __syncthreads();
        {
            const int g = wid >> 1, nh = wid & 1;
            f32x4 acc[4][4];
#pragma unroll
            for (int m = 0; m < 4; ++m)
#pragma unroll
                for (int n = 0; n < 4; ++n) acc[m][n] = (f32x4){0.f, 0.f, 0.f, 0.f};
#pragma unroll
            for (int kk = 0; kk < 4; ++kk) {
                bf16x8 Af[4], Bf[4];
#pragma unroll
                for (int m = 0; m < 4; ++m) Af[m] = *(const bf16x8*)(pa + (16 * m + fr) * 520 + g * 128 + kk * 32 + fq * 8);
#pragma unroll
                for (int n = 0; n < 4; ++n) Bf[n] = *(const bf16x8*)(PWt + g * 16384 + (nh * 64 + 16 * n + fr) * 128 + kk * 32 + fq * 8);
#pragma unroll
                for (int m = 0; m < 4; ++m)
#pragma unroll
                    for (int n = 0; n < 4; ++n) acc[m][n] = __builtin_amdgcn_mfma_f32_16x16x32_bf16(Bf[n], Af[m], acc[m][n], 0, 0, 0);
            }
            float ssq[4];
#pragma unroll
            for (int m = 0; m < 4; ++m) {
                const int t = 16 * m + fr; float s = 0.f;
#pragma unroll
                for (int n = 0; n < 4; ++n) {
                    const int dch = g * 128 + nh * 64 + 16 * n + 4 * fq;
                    const uint2 zz = *(const uint2*)(pR + (size_t)(tok0 + t) * 1024 + 512 + dch);
                    const f32x4 ps = *(const f32x4*)(pscale + dch);
                    const float z0 = __uint_as_float(zz.x << 16), z1 = __uint_as_float(zz.x & 0xffff0000u), z2 = __uint_as_float(zz.y << 16), z3 = __uint_as_float(zz.y & 0xffff0000u);
                    f32x4 v = acc[m][n];
                    v[0] = v[0] * ps[0] * silu(z0); v[1] = v[1] * ps[1] * silu(z1); v[2] = v[2] * ps[2] * silu(z2); v[3] = v[3] * ps[3] * silu(z3);
                    acc[m][n] = v;
                    s += v[0] * v[0] + v[1] * v[1] + v[2] * v[2] + v[3] * v[3];
                }
                s += __shfl_xor(s, 16); s += __shfl_xor(s, 32);
                ssq[m] = s;
            }
            if (fq == 0) {
#pragma unroll
                for (int m = 0; m < 4; ++m) part[wid * 64 + 16 * m + fr] = ssq[m];
            }
            __syncthreads();
            if (tid < 64) { float s = 0.f; for (int w = 0; w < 8; ++w) s += part[w * 64 + tid]; rs[tid] = rsqrtf(s * (1.0f / 512.0f) + 1e-6f); }
            __syncthreads();
#pragma unroll
            for (int m = 0; m < 4; ++m) {
                const int t = 16 * m + fr; const float r = rs[t];
#pragma unroll
                for (int n = 0; n < 4; ++n) {
                    const int dch = g * 128 + nh * 64 + 16 * n + 4 * fq;
                    const f32x4 ng = *(const f32x4*)(npg + dch);
                    const f32x4 v = acc[m][n];
                    uint2 w; w.x = cvt_pk_bf16(v[0] * r * ng[0], v[1] * r * ng[1]); w.y = cvt_pk_bf16(v[2] * r * ng[2], v[3] * r * ng[3]);
                    *(uint2*)(A2 + (size_t)(tok0 + t) * 1024 + 512 + dch) = w;
                }
            }
        }
    }
}

__device__ __forceinline__ void ph_final(const Params& p) {
    const float* __restrict__ x = p.in[0]; const float* __restrict__ pg = p.in[19];
    const float* __restrict__ ob = (const float*)(p.ws + WS_OUTB);
    float* __restrict__ out = p.out;
    const int lane = threadIdx.x & 63, wid = threadIdx.x >> 6;
    float4 g4[4];
#pragma unroll
    for (int i = 0; i < 4; ++i) g4[i] = ((const float4*)pg)[lane + 64 * i];
    for (int row = blockIdx.x * 8 + wid; row < NTOK; row += gridDim.x * 8) {
        const float4* orow = (const float4*)(ob + (size_t)row * DM); const float4* xr = (const float4*)(x + (size_t)row * DM);
        float4 o4[4]; float ss = 0.f;
#pragma unroll
        for (int i = 0; i < 4; ++i) { o4[i] = orow[lane + 64 * i]; ss += o4[i].x * o4[i].x + o4[i].y * o4[i].y + o4[i].z * o4[i].z + o4[i].w * o4[i].w; }
        ss = wave_sum(ss);
        const float r = rsqrtf(ss * (1.0f / DM) + 1e-6f);
#pragma unroll
        for (int i = 0; i < 4; ++i) {
            const float4 xv = xr[lane + 64 * i]; float4 y;
            y.x = xv.x + o4[i].x * r * g4[i].x; y.y = xv.y + o4[i].y * r * g4[i].y; y.z = xv.z + o4[i].z * r * g4[i].z; y.w = xv.w + o4[i].w * r * g4[i].w;
            ((float4*)(out + (size_t)row * DM))[lane + 64 * i] = y;
        }
    }
}

__global__ void __launch_bounds__(512, 2) hyena_fwd(Params p) {
    extern __shared__ __attribute__((aligned(16))) unsigned char smem[];
    cg::grid_group grid = cg::this_grid();
#define PH_ON(i) (p.phase_lo <= (i) && (i) < p.phase_hi)
#define PH_SYNC(i) do { if (PH_ON(i) && (i) + 1 < p.phase_hi) grid.sync(); } while (0)
    if (PH_ON(0)) {
        ph_rmsnorm_in(p.in[0], (bf16_t*)(p.ws + WS_XN));
        ph_weights(p);
        ph_filters(p, (float*)smem);
    }
    PH_SYNC(0);
    if (PH_ON(1)) {
        pg8::StaticOrder S;
        { pg8::Gemm g{(const bf16_t*)(p.ws + WS_W1T), (const bf16_t*)(p.ws + WS_XN), 2048, NTOK, 1024};
          pg8::EpiBf16<0> E{(bf16_t*)(p.ws + WS_PT), NTOK, nullptr, 0, 0};
          S.init(g.M, g.N, gridDim.x, blockIdx.x);
          pg8::gemm_phase<pg8::EpiBf16<0>, pg8::StaticOrder, false>((PG8_LAS unsigned char*)smem, g, S, E, nullptr); }
        __syncthreads();
        { pg8::Gemm g{(const bf16_t*)(p.ws + WS_XN), (const bf16_t*)(p.ws + WS_W1T) + (size_t)2048 * 1024, NTOK, 1024, 1024};
          pg8::EpiBf16<0> E{(bf16_t*)(p.ws + WS_PR), 1024, nullptr, 0, 0};
          S.init(g.M, g.N, gridDim.x, blockIdx.x);
          pg8::gemm_phase<pg8::EpiBf16<0>, pg8::StaticOrder, false>((PG8_LAS unsigned char*)smem, g, S, E, nullptr); }
    }
    PH_SYNC(1);
    if (PH_ON(2)) ph_fftconv(p, (float2*)smem);
    PH_SYNC(2);
    if (PH_ON(3)) ph_mix(p, smem);
    PH_SYNC(3);
    if (PH_ON(4)) {
        pg8::StaticOrder S;
        pg8::Gemm g{(const bf16_t*)(p.ws + WS_A2), (const bf16_t*)(p.ws + WS_W2T), NTOK, 1024, 1024};
        pg8::EpiF32 E{(float*)(p.ws + WS_OUTB), 1024, nullptr};
        S.init(g.M, g.N, gridDim.x, blockIdx.x);
        pg8::gemm_phase<pg8::EpiF32, pg8::StaticOrder, false>((PG8_LAS unsigned char*)smem, g, S, E, nullptr);
    }
    PH_SYNC(4);
    if (PH_ON(5)) ph_final(p);
}

#ifndef COOP
#define COOP 0
#endif
extern "C" void kernel_launch(void* const* d_in, const int* in_sizes, int n_in, void* d_out, int out_size, void* d_ws, size_t ws_size, hipStream_t stream) {
    static int grid_blocks = 0;
    if (!grid_blocks) {
        int dev = 0, cus = 0, per_cu = 0;
        (void)hipGetDevice(&dev);
        (void)hipDeviceGetAttribute(&cus, hipDeviceAttributeMultiprocessorCount, dev);
        (void)hipFuncSetAttribute((const void*)hyena_fwd, hipFuncAttributeMaxDynamicSharedMemorySize, LDS_BYTES);
        (void)hipOccupancyMaxActiveBlocksPerMultiprocessor(&per_cu, (const void*)hyena_fwd, NTHREADS, LDS_BYTES);
        if (per_cu < 1) { fprintf(stderr, "occupancy query says %d blocks/CU\n", per_cu); per_cu = 1; }
        grid_blocks = cus * 1;
        (void)hipGetLastError();
    }
    Params p{};
    for (int i = 0; i < 20; ++i) p.in[i] = (const float*)d_in[i];
    p.out = (float*)d_out; p.ws = (unsigned char*)d_ws;
#if COOP
    p.phase_lo = 0; p.phase_hi = NPHASE;
    void* args[] = {&p};
    hipError_t e = hipLaunchCooperativeKernel((const void*)hyena_fwd, dim3(grid_blocks), dim3(NTHREADS), args, LDS_BYTES, stream);
    if (e != hipSuccess) fprintf(stderr, "cooperative launch failed: %s (grid %d)\n", hipGetErrorString(e), grid_blocks);
#else
    for (int ph = 0; ph < NPHASE; ++ph) {
        p.phase_lo = ph; p.phase_hi = ph + 1;
        hipLaunchKernelGGL(hyena_fwd, dim3(grid_blocks), dim3(NTHREADS), LDS_BYTES, stream, p);
    }
#endif
}
```

```cpp
#include <hip/hip_runtime.h>
#include <hip/hip_cooperative_groups.h>
#include <cstdio>
namespace cg = cooperative_groups;
namespace pg8 {
#define PG8_LAS __attribute__((address_space(3)))
typedef unsigned short bf16_t;
typedef short bf16x8 __attribute__((ext_vector_type(8)));
typedef float f32x4 __attribute__((ext_vector_type(4)));
typedef unsigned u32x4 __attribute__((ext_vector_type(4)));
constexpr int BM = 256, BK = 64, HALF = 128, HTB = HALF * BK * 2  , STAGE_BYTES = 8 * HTB, NXCD = 8, WGM = 8;

__host__ __device__ __forceinline__ int lds_byte(int r, int c) { const int st = (r >> 4) * 2 + (c >> 5), rr = r & 15, cc = c & 31, ob = rr * 64 + cc * 2; return st * 1024 + (ob ^ (((ob >> 9) & 1) << 5)); }
__host__ __device__ __forceinline__ void stage_rc(int b, int& R, int& C) { const int st = b / 1024, sb = b % 1024, swz = sb ^ (((sb >> 9) & 1) << 5); R = (st >> 1) * 16 + swz / 64; C = (st & 1) * 32 + (swz % 64) / 2; }
__host__ __device__ __forceinline__ int perm32(int rho) { const int n = rho >> 4, i = rho & 15; return 8 * (i >> 2) + 4 * n + (i & 3); }
struct Unit { int pm, pn; };
struct Gemm { const bf16_t* A; const bf16_t* Bt; int M, N, K; };

struct StaticOrder {
    int nM, nN, nwg, G, c;
    __host__ __device__ void init(int M, int N, int G_, int c_) { nM = M / BM; nN = N / BM; nwg = nM * nN; G = G_; c = c_; }
    __host__ __device__ bool next(int i, Unit& u) const {
        const long L = (long)i * G + c; if (L >= nwg) return false;
        int wgid = (int)L; { const int q = nwg / NXCD, r = nwg % NXCD, xcd = wgid % NXCD, off = wgid / NXCD; wgid = (xcd < r ? xcd * (q + 1) : r * (q + 1) + (xcd - r) * q) + off; }
        const int nig = WGM * nN, gid = wgid / nig, fm = gid * WGM, gsz = (nM - fm) < WGM ? (nM - fm) : WGM;
        u.pm = fm + ((wgid % nig) % gsz); u.pn = (wgid % nig) / gsz; return true;
    }
    __device__ __forceinline__ void a_ready(const Unit&) const {}
    __device__ __forceinline__ void done(const Unit&) const {}
};
__device__ __forceinline__ unsigned cvt_pk_bf16(float lo, float hi) { unsigned r; asm volatile("v_cvt_pk_bf16_f32 %0, %1, %2" : "=v"(r) : "v"(lo), "v"(hi)); return r; }
typedef float f32x2 __attribute__((ext_vector_type(2)));
__device__ __forceinline__ f32x2 gelu_pk(f32x2 v) {
    const f32x2 av = __builtin_elementwise_abs(v), d = av * 0.2316418882f + 1.0f;
    f32x2 t; t.x = __builtin_amdgcn_rcpf(d.x); t.y = __builtin_amdgcn_rcpf(d.y);
    f32x2 q = t * 0.5307027145f + (-0.7265760135f); q = q * t + 0.7107068705f; q = q * t + (-0.142248368f); q = q * t + 0.127414796f; q = q * t;
    const f32x2 s = (v * v) * (-0.72134752044f);
    f32x2 e; e.x = __builtin_amdgcn_exp2f(s.x); e.y = __builtin_amdgcn_exp2f(s.y);
    const f32x2 m = v * (q * e), r = v - m;
    f32x2 o; o.x = v.x < 0.f ? m.x : r.x; o.y = v.y < 0.f ? m.y : r.y; return o;
}

struct EpiF32 {
    static constexpr bool PERM = false, AFTER_DRAIN = false;
    float* C; int ldc; const float* bias;
    __device__ __forceinline__ void operator()(const f32x4 (&acc)[2][2][4][2], const Unit& u, int wr, int wc, int fr, int fq) const {
        const int row0 = u.pm * BM + wr * 64 + fr, col0 = u.pn * BM + wc * 32 + 4 * fq;
        f32x4 bv[2][2];
#pragma unroll
        for (int bj = 0; bj < 2; ++bj)
#pragma unroll
            for (int n = 0; n < 2; ++n) bv[bj][n] = bias ? *(const f32x4*)(bias + col0 + bj * HALF + n * 16) : (f32x4){0.f, 0.f, 0.f, 0.f};
#pragma unroll
        for (int ai = 0; ai < 2; ++ai)
#pragma unroll
            for (int m = 0; m < 4; ++m) { float* rowp = C + (size_t)(row0 + ai * HALF + m * 16) * ldc + col0;
#pragma unroll
                for (int bj = 0; bj < 2; ++bj)
#pragma unroll
                    for (int n = 0; n < 2; ++n) *(f32x4*)(rowp + bj * HALF + n * 16) = acc[ai][bj][m][n] + bv[bj][n]; }
    }
};
template <int ACT  > struct EpiBf16 {
    static constexpr bool PERM = true, AFTER_DRAIN = false;
    bf16_t* O; int ldc; const float* bias; int split_cols; size_t split_stride;
    __device__ __forceinline__ void operator()(const f32x4 (&acc)[2][2][4][2], const Unit& u, int wr, int wc, int fr, int fq) const {
        const int row0 = u.pm * BM + wr * 64 + fr; int colt = u.pn * BM; bf16_t* base = O;
        if (split_cols) { const int t = colt / split_cols; base += (size_t)t * split_stride; colt -= t * split_cols; }
        const int col0 = colt + wc * 32 + 8 * fq, bcol0 = u.pn * BM + wc * 32 + 8 * fq;
        f32x4 bv[2][2];
#pragma unroll
        for (int bj = 0; bj < 2; ++bj)
#pragma unroll
            for (int n = 0; n < 2; ++n) bv[bj][n] = bias ? *(const f32x4*)(bias + bcol0 + bj * HALF + 4 * n) : (f32x4){0.f, 0.f, 0.f, 0.f};
#pragma unroll
        for (int ai = 0; ai < 2; ++ai)
#pragma unroll
            for (int m = 0; m < 4; ++m) { bf16_t* rowp = base + (size_t)(row0 + ai * HALF + m * 16) * ldc + col0;
#pragma unroll
                for (int bj = 0; bj < 2; ++bj) { f32x4 v0 = acc[ai][bj][m][0] + bv[bj][0], v1 = acc[ai][bj][m][1] + bv[bj][1];
                    if (ACT == 1) { f32x2 a = gelu_pk((f32x2){v0[0], v0[1]}), b = gelu_pk((f32x2){v0[2], v0[3]}), c = gelu_pk((f32x2){v1[0], v1[1]}), d = gelu_pk((f32x2){v1[2], v1[3]});
                        v0 = (f32x4){a.x, a.y, b.x, b.y}; v1 = (f32x4){c.x, c.y, d.x, d.y}; }
                    if (ACT == 2) {
#pragma unroll
                        for (int j = 0; j < 4; ++j) { v0[j] = 0.5f * v0[j] * (1.0f + erff(v0[j] * 0.70710678f)); v1[j] = 0.5f * v1[j] * (1.0f + erff(v1[j] * 0.70710678f)); } }
                    u32x4 w; w.x = cvt_pk_bf16(v0[0], v0[1]); w.y = cvt_pk_bf16(v0[2], v0[3]); w.z = cvt_pk_bf16(v1[0], v1[1]); w.w = cvt_pk_bf16(v1[2], v1[3]);
                    *(u32x4*)(rowp + bj * HALF) = w; } }
    }
};

template <class Epi, class Sched, bool STAMP = false>
__device__ __forceinline__ void gemm_phase(PG8_LAS unsigned char* lds, const Gemm g, const Sched& S, const Epi& E, unsigned long long* stamps) {
    const int tid = threadIdx.x, wid = __builtin_amdgcn_readfirstlane(tid >> 6), lane = tid & 63, wr = wid >> 2, wc = wid & 3, fr = lane & 15, fq = lane >> 4;
    const int K = g.K, nt = K / BK;
    int ts_lo = 0, ts_hi = 0, nts = 0; const unsigned long long rt_entry = STAMP ? (unsigned long long)wall_clock64() : 0ull;
#define PG8_STAMP() do { if (STAMP && wid == 0 && nts < 64) { const unsigned long long _c = (unsigned long long)clock64(); \
        ts_lo = (lane == nts) ? (int)(unsigned)_c : ts_lo; ts_hi = (lane == nts) ? (int)(unsigned)(_c >> 32) : ts_hi; ++nts; } } while (0)
    PG8_STAMP();
    unsigned voffA[2], voffB[2];
#pragma unroll
    for (int i = 0; i < 2; ++i) { int R, C; stage_rc(tid * 16 + i * 8192, R, C); const int Rb = Epi::PERM ? ((R & ~31) + perm32(R & 31)) : R;
        voffA[i] = (unsigned)(R * K + C) * 2u; voffB[i] = (unsigned)(Rb * K + C) * 2u; }
    const size_t kstep = (size_t)(BK * 2);
    const size_t hstep = (size_t)HALF * K * 2;
    const size_t tstep = 2 * hstep;
    const unsigned ldsw = (unsigned)wid * 1024u;
    const int aoff = lds_byte(wr * 64 + fr, fq * 8), boff = lds_byte(wc * 32 + fr, fq * 8);
#define PG8_SA(b, h) (((b) * 2 + (h)) * HTB)
#define PG8_SB(b, h) ((4 + (b) * 2 + (h)) * HTB)
#define PG8_STAGE(bufoff, gbase, voff) do { _Pragma("unroll") for (int _i = 0; _i < 2; ++_i) \
        __builtin_amdgcn_global_load_lds((const unsigned*)((const char*)(gbase) + (voff)[_i]), (PG8_LAS unsigned*)(lds + (bufoff) + ldsw + _i * 8192), 16, 0, 0); } while (0)
#define PG8_LDA(dst, b, h) do { _Pragma("unroll") for (int m = 0; m < 4; ++m) _Pragma("unroll") for (int k = 0; k < 2; ++k) dst[m][k] = *(const PG8_LAS bf16x8*)(lds + PG8_SA(b, h) + aoff + m * 2048 + k * 1024); } while (0)
#define PG8_LDB(dst, b, h) do { _Pragma("unroll") for (int n = 0; n < 2; ++n) _Pragma("unroll") for (int k = 0; k < 2; ++k) dst[n][k] = *(const PG8_LAS bf16x8*)(lds + PG8_SB(b, h) + boff + n * 2048 + k * 1024); } while (0)
#define PG8_MMA(ai, bj, At, Bt) do { __builtin_amdgcn_s_setprio(1); _Pragma("unroll") for (int m = 0; m < 4; ++m) _Pragma("unroll") for (int n = 0; n < 2; ++n) _Pragma("unroll") for (int k = 0; k < 2; ++k) \
        acc[ai][bj][m][n] = __builtin_amdgcn_mfma_f32_16x16x32_bf16(Bt[n][k], At[m][k], acc[ai][bj][m][n], 0, 0, 0); __builtin_amdgcn_s_setprio(0); } while (0)
#define PG8_WAIT_V(n) asm volatile("s_waitcnt vmcnt(" #n ")" ::: "memory")
#define PG8_WAIT_L(n) asm volatile("s_waitcnt lgkmcnt(" #n ")" ::: "memory")
#define PG8_BAR __builtin_amdgcn_s_barrier()
#define PG8_SCHED __builtin_amdgcn_sched_barrier(0)
    Unit cur, nxt; int ui = 0;
    if (!S.next(0, cur)) return;
    f32x4 acc[2][2][4][2];
#pragma unroll
    for (int a = 0; a < 2; ++a)
#pragma unroll
        for (int b = 0; b < 2; ++b)
#pragma unroll
            for (int m = 0; m < 4; ++m)
#pragma unroll
                for (int n = 0; n < 2; ++n) acc[a][b][m][n] = (f32x4){0.f, 0.f, 0.f, 0.f};
    bf16x8 At[4][2], B0[2][2], B1[2][2];
    const char* cA = (const char*)g.A + (size_t)cur.pm * tstep; const char* cB = (const char*)g.Bt + (size_t)cur.pn * tstep;
    S.a_ready(cur);
    PG8_STAGE(PG8_SB(0, 0), cB, voffB); PG8_STAGE(PG8_SA(0, 0), cA, voffA); PG8_STAGE(PG8_SB(0, 1), cB + hstep, voffB); PG8_STAGE(PG8_SA(0, 1), cA + hstep, voffA);
    if (wr == 1) PG8_BAR;
    PG8_WAIT_V(4); PG8_BAR;
    PG8_STAGE(PG8_SB(1, 0), cB + kstep, voffB); PG8_STAGE(PG8_SA(1, 0), cA + kstep, voffA); PG8_STAGE(PG8_SB(1, 1), cB + hstep + kstep, voffB);
    PG8_WAIT_V(6); PG8_BAR;
    PG8_STAMP();
    for (;;) {
        const bool has_next = S.next(ui + 1, nxt);
        const char* nA = has_next ? (const char*)g.A + (size_t)nxt.pm * tstep : cA; const char* nB = has_next ? (const char*)g.Bt + (size_t)nxt.pn * tstep : cB;
        for (int t = 0; t < nt; t += 2) {
            const bool last = (t == nt - 2);
            const char* a1 = cA + (size_t)(t + 1) * kstep;
            const char* a2 = last ? nA : cA + (size_t)(t + 2) * kstep; const char* b2 = last ? nB : cB + (size_t)(t + 2) * kstep;
            const char* a3 = a2 + kstep; const char* b3 = b2 + kstep;
            if (last && has_next) S.a_ready(nxt);
            PG8_LDB(B0, 0, 0); PG8_SCHED; PG8_LDA(At, 0, 0); PG8_STAGE(PG8_SA(1, 1), a1 + hstep, voffA);
            PG8_WAIT_L(8); PG8_BAR; PG8_WAIT_L(0); PG8_MMA(0, 0, At, B0); PG8_BAR; PG8_SCHED;
            PG8_LDB(B1, 0, 1); PG8_STAGE(PG8_SB(0, 0), b2, voffB);
            PG8_BAR; PG8_WAIT_L(0); PG8_MMA(0, 1, At, B1); PG8_BAR;
            PG8_LDA(At, 0, 1); PG8_STAGE(PG8_SA(0, 0), a2, voffA);
            PG8_BAR; PG8_WAIT_L(0); PG8_MMA(1, 0, At, B0); PG8_BAR; PG8_SCHED;
            PG8_STAGE(PG8_SB(0, 1), b2 + hstep, voffB);
            PG8_WAIT_V(6); PG8_BAR; PG8_MMA(1, 1, At, B1); PG8_BAR;
            PG8_LDB(B0, 1, 0); PG8_SCHED; PG8_LDA(At, 1, 0); PG8_STAGE(PG8_SA(0, 1), a2 + hstep, voffA);
            PG8_WAIT_L(8); PG8_BAR; PG8_WAIT_L(0); PG8_MMA(0, 0, At, B0); PG8_BAR; PG8_SCHED;
            PG8_LDB(B1, 1, 1); PG8_STAGE(PG8_SB(1, 0), b3, voffB);
            PG8_BAR; PG8_WAIT_L(0); PG8_MMA(0, 1, At, B1); PG8_BAR;
            PG8_LDA(At, 1, 1); PG8_STAGE(PG8_SA(1, 0), a3, voffA);
            PG8_BAR; PG8_WAIT_L(0); PG8_MMA(1, 0, At, B0); PG8_BAR; PG8_SCHED;
            PG8_STAGE(PG8_SB(1, 1), b3 + hstep, voffB);
            PG8_WAIT_V(6); PG8_BAR; PG8_MMA(1, 1, At, B1); PG8_BAR;
        }
        PG8_STAMP();
        if constexpr (!Epi::AFTER_DRAIN) { E(acc, cur, wr, wc, fr, fq); S.done(cur); }
        PG8_STAMP();
        if (!has_next) break;
#pragma unroll
        for (int a = 0; a < 2; ++a)
#pragma unroll
            for (int b = 0; b < 2; ++b)
#pragma unroll
                for (int m = 0; m < 4; ++m)
#pragma unroll
                    for (int n = 0; n < 2; ++n) acc[a][b][m][n] = (f32x4){0.f, 0.f, 0.f, 0.f};
        cur = nxt; cA = nA; cB = nB; ++ui;
    }
    PG8_WAIT_V(0);
    if (wr == 0) PG8_BAR;
    PG8_BAR;
    if constexpr (Epi::AFTER_DRAIN) { E.fused(acc, cur, wr, wc, fr, fq, lds, wid, lane); S.done(cur); }
    PG8_STAMP();
    if (STAMP && wid == 0) { stamps[lane] = lane < nts ? (((unsigned long long)(unsigned)ts_hi << 32) | (unsigned)ts_lo) : 0ull;
        if (lane == 62) stamps[62] = rt_entry; if (lane == 63) stamps[63] = (unsigned long long)wall_clock64(); }
#undef PG8_STAMP
#undef PG8_SA
#undef PG8_SB
#undef PG8_STAGE
#undef PG8_LDA
#undef PG8_LDB
#undef PG8_MMA
#undef PG8_WAIT_V
#undef PG8_WAIT_L
#undef PG8_BAR
#undef PG8_SCHED
}
}
using pg8::bf16_t; using pg8::bf16x8; using pg8::f32x4; using pg8::u32x4; using pg8::cvt_pk_bf16;

constexpr int DM = 1024, NBATCH = 4, SEQ = 8192, NTOK = NBATCH * SEQ, HWD = 512, FN = 16384;
constexpr int NTHREADS = 512;
constexpr size_t MBY = 1024 * 1024;
constexpr size_t WS_XN = 0, WS_PT = 64 * MBY, WS_PR = 192 * MBY, WS_KF = 256 * MBY, WS_GT = 320 * MBY, WS_W1T = 352 * MBY, WS_W2T = 358 * MBY, WS_PWT = 360 * MBY, WS_KS = 361 * MBY, WS_BAR = 430 * MBY;
constexpr size_t WS_A2 = WS_XN, WS_OUTB = WS_PT;
constexpr int LDS_BYTES = 154624;
constexpr int NPHASE = 6;

struct Params {
    const float* in[20];
    float* out;
    unsigned char* ws;
    int phase_lo, phase_hi;
};

__device__ __forceinline__ float bf2f(bf16_t v) { return __uint_as_float((unsigned)v << 16); }
__device__ __forceinline__ bf16_t f2bf(float v) { return (bf16_t)(cvt_pk_bf16(v, 0.f) & 0xffffu); }
__device__ __forceinline__ float wave_sum(float v) {
#pragma unroll
    for (int o = 32; o; o >>= 1) v += __shfl_xor(v, o);
    return v;
}
__device__ __forceinline__ float silu(float z) { return z * __builtin_amdgcn_rcpf(1.0f + __expf(-z)); }

__device__ __forceinline__ void ph_rmsnorm_in(const float* __restrict__ x, bf16_t* __restrict__ xn, int vb, int nvb) {
    const int lane = threadIdx.x & 63, wid = threadIdx.x >> 6;
    for (int row0 = (vb * 8 + wid) * 2; row0 < NTOK; row0 += nvb * 16) {
        float4 a[2][4];
#pragma unroll
        for (int rr = 0; rr < 2; ++rr) {
            const float4* xr = (const float4*)(x + (size_t)(row0 + rr) * DM);
            a[rr][0] = xr[lane * 2]; a[rr][1] = xr[lane * 2 + 1]; a[rr][2] = xr[128 + lane * 2]; a[rr][3] = xr[129 + lane * 2];
        }
#pragma unroll
        for (int rr = 0; rr < 2; ++rr) {
            float ss = 0.f;
#pragma unroll
            for (int i = 0; i < 4; ++i) ss += a[rr][i].x * a[rr][i].x + a[rr][i].y * a[rr][i].y + a[rr][i].z * a[rr][i].z + a[rr][i].w * a[rr][i].w;
            ss = wave_sum(ss);
            const float r = rsqrtf(ss * (1.0f / DM) + 1e-6f);
            u32x4 w0, w1;
            w0.x = cvt_pk_bf16(a[rr][0].x * r, a[rr][0].y * r); w0.y = cvt_pk_bf16(a[rr][0].z * r, a[rr][0].w * r); w0.z = cvt_pk_bf16(a[rr][1].x * r, a[rr][1].y * r); w0.w = cvt_pk_bf16(a[rr][1].z * r, a[rr][1].w * r);
            w1.x = cvt_pk_bf16(a[rr][2].x * r, a[rr][2].y * r); w1.y = cvt_pk_bf16(a[rr][2].z * r, a[rr][2].w * r); w1.z = cvt_pk_bf16(a[rr][3].x * r, a[rr][3].y * r); w1.w = cvt_pk_bf16(a[rr][3].z * r, a[rr][3].w * r);
            *(u32x4*)(xn + (size_t)(row0 + rr) * DM + lane * 8) = w0;
            *(u32x4*)(xn + (size_t)(row0 + rr) * DM + 512 + lane * 8) = w1;
        }
    }
}

template <int PART> __device__ __forceinline__ void ph_weights(const Params& p, int vb, int nvb) {
    const int gt = vb * NTHREADS + threadIdx.x, gs = nvb * NTHREADS;
    const float* __restrict__ w_in = p.in[2]; const float* __restrict__ g = p.in[1];
    const float* __restrict__ w_out = p.in[18]; const float* __restrict__ pw = p.in[14];
    bf16_t* W1t = (bf16_t*)(p.ws + WS_W1T); bf16_t* W2t = (bf16_t*)(p.ws + WS_W2T); bf16_t* PWt = (bf16_t*)(p.ws + WS_PWT);
    if (PART != 1) for (int i = gt; i < 128 * 3072; i += gs) {
        const int n = i % 3072, k8 = i / 3072; float v[8];
#pragma unroll
        for (int e = 0; e < 8; ++e) v[e] = w_in[(size_t)(k8 * 8 + e) * 3072 + n] * g[k8 * 8 + e];
        u32x4 w; w.x = cvt_pk_bf16(v[0], v[1]); w.y = cvt_pk_bf16(v[2], v[3]); w.z = cvt_pk_bf16(v[4], v[5]); w.w = cvt_pk_bf16(v[6], v[7]);
        *(u32x4*)(W1t + (size_t)n * 1024 + k8 * 8) = w;
    }
    if (PART != 0) for (int i = gt; i < 128 * 1024; i += gs) {
        const int n = i & 1023, k8 = i >> 10; float v[8];
#pragma unroll
        for (int e = 0; e < 8; ++e) v[e] = w_out[(size_t)(k8 * 8 + e) * 1024 + n];
        u32x4 w; w.x = cvt_pk_bf16(v[0], v[1]); w.y = cvt_pk_bf16(v[2], v[3]); w.z = cvt_pk_bf16(v[4], v[5]); w.w = cvt_pk_bf16(v[6], v[7]);
        *(u32x4*)(W2t + (size_t)n * 1024 + k8 * 8) = w;
    }
    if (PART != 0) for (int i = gt; i < 4 * 16 * 128; i += gs) {
        const int d = i & 127, c8 = (i >> 7) & 15, gq = i >> 11; float v[8];
#pragma unroll
        for (int e = 0; e < 8; ++e) v[e] = pw[gq * 16384 + (c8 * 8 + e) * 128 + d];
        u32x4 w; w.x = cvt_pk_bf16(v[0], v[1]); w.y = cvt_pk_bf16(v[2], v[3]); w.z = cvt_pk_bf16(v[4], v[5]); w.w = cvt_pk_bf16(v[6], v[7]);
        *(u32x4*)(PWt + gq * 16384 + d * 128 + c8 * 8) = w;
    }
}

template <int KIN, int INSTRIDE> __device__ __forceinline__ void filt_layer(const float* __restrict__ hin, const float* __restrict__ wl, const float* __restrict__ bl, const float* __restrict__ fql, float* __restrict__ hout) {
    const int n = threadIdx.x & 63, pg = threadIdx.x >> 6;
    float acc[4];
#pragma unroll
    for (int i = 0; i < 4; ++i) acc[i] = bl[n];
#pragma unroll 8
    for (int f = 0; f < KIN; ++f) {
        const float w = wl[f * 64 + n];
#pragma unroll
        for (int i = 0; i < 4; ++i) acc[i] += hin[(pg * 4 + i) * INSTRIDE + f] * w;
    }
    const float fr = fql[n];
#pragma unroll
    for (int i = 0; i < 4; ++i) hout[(pg * 4 + i) * 64 + n] = __sinf(fr * acc[i]);
}
typedef _Float16 f16x8 __attribute__((ext_vector_type(8)));
typedef _Float16 f16x2 __attribute__((ext_vector_type(2)));
__device__ __forceinline__ unsigned pk_f16(float a, float b) { f16x2 h; h.x = (_Float16)a; h.y = (_Float16)b; return __builtin_bit_cast(unsigned, h); }
__device__ __forceinline__ void ph_filters(const Params& p, float* smf, int vb, int nvb) {
    float* wl1 = smf;
    float* wl2 = wl1 + 33 * 64;
    float* wl3 = wl2 + 64 * 64;
    float* bl = wl3 + 64 * 64;
    float* fql = bl + 192;
    float* zs = fql + 64;
    float* ha = zs + 32 * 36;
    float* hb = ha + 32 * 64;
    _Float16* h3h = (_Float16*)(hb + 32 * 64);
    _Float16* wT = h3h + 2 * 32 * 72;
    const float* __restrict__ w1 = p.in[5]; const float* __restrict__ b1 = p.in[6];
    const float* __restrict__ w2 = p.in[7]; const float* __restrict__ b2 = p.in[8];
    const float* __restrict__ w3 = p.in[9]; const float* __restrict__ b3 = p.in[10];
    const float* __restrict__ fq_ = p.in[11]; const float* __restrict__ wo = p.in[12];
    _Float16* __restrict__ kf = (_Float16*)(p.ws + WS_KF);
    const int tid = threadIdx.x, lane = tid & 63, wid = tid >> 6, fr = lane & 15, fq = lane >> 4;
    for (int i = tid; i < 33 * 64; i += NTHREADS) wl1[i] = w1[i];
    for (int i = tid; i < 64 * 64; i += NTHREADS) { wl2[i] = w2[i]; wl3[i] = w3[i]; }
    if (tid < 64) { bl[tid] = b1[tid]; bl[64 + tid] = b2[tid]; bl[128 + tid] = b3[tid]; fql[tid] = fq_[tid]; }
    for (int tbase = 2 * vb; tbase < SEQ / 32; tbase += 2 * nvb) {
        const int ntl = 2;
        for (int ti = 0; ti < ntl; ++ti) {
            const int l0 = (tbase + ti) * 32;
            __syncthreads();
            for (int i = tid; i < 32 * 33; i += NTHREADS) {
                const int pp = i / 33, f = i % 33, l = l0 + pp; float val;
                if (f == 0) val = (float)l * (1.0f / (float)(SEQ - 1));
                else {
                    const int bi = (f - 1) & 15;
                    const float band = 1e-4f + (float)bi * ((15.0f - 1e-4f) / 15.0f);
                    const float ang = 2.0f * 3.14159265358979323846f * (float)l / (float)SEQ;
                    const float a = band * ang;
                    val = (f <= 16) ? cosf(a) : -sinf(a);
                }
                zs[pp * 36 + f] = val;
            }
            __syncthreads();
            filt_layer<33, 36>(zs, wl1, bl, fql, ha);
            __syncthreads();
            filt_layer<64, 64>(ha, wl2, bl + 64, fql, hb);
            __syncthreads();
            filt_layer<64, 64>(hb, wl3, bl + 128, fql, ha);
            __syncthreads();
            for (int i = tid; i < 32 * 32; i += NTHREADS) { const int pp = i >> 5, k2 = (i & 31) * 2; *(unsigned*)(h3h + (ti * 32 + pp) * 72 + k2) = pk_f16(ha[pp * 64 + k2], ha[pp * 64 + k2 + 1]); }
        }
#pragma unroll 1
        for (int q = 0; q < 4; ++q) {
            __syncthreads();
            {
                const int c4 = tid & 127, k8 = tid >> 7;
#pragma unroll
                for (int hh = 0; hh < 2; ++hh) {
                    const int k0 = (k8 * 2 + hh) * 8;
                    f32x4 v[8];
#pragma unroll
                    for (int kk = 0; kk < 8; ++kk) v[kk] = *(const f32x4*)(wo + (size_t)(k0 + kk) * 2048 + q * 512 + c4 * 4);
#pragma unroll
                    for (int e = 0; e < 4; ++e) {
                        u32x4 w; w.x = pk_f16(v[0][e], v[1][e]); w.y = pk_f16(v[2][e], v[3][e]); w.z = pk_f16(v[4][e], v[5][e]); w.w = pk_f16(v[6][e], v[7][e]);
                        *(u32x4*)(wT + (c4 * 4 + e) * 72 + k0) = w;
                    }
                }
            }
            __syncthreads();
            const int o = q >> 1, dir = q & 1;
            f16x8 Bf[4][2];
#pragma unroll
            for (int n = 0; n < 4; ++n)
#pragma unroll
                for (int ks = 0; ks < 2; ++ks) Bf[n][ks] = *(const f16x8*)(wT + (wid * 64 + 16 * n + fr) * 72 + ks * 32 + fq * 8);
            for (int ti = 0; ti < ntl; ++ti) {
                const int l0 = (tbase + ti) * 32;
#pragma unroll
                for (int m = 0; m < 2; ++m) {
                    f16x8 Af[2];
#pragma unroll
                    for (int ks = 0; ks < 2; ++ks) Af[ks] = *(const f16x8*)(h3h + (ti * 32 + 16 * m + fr) * 72 + ks * 32 + fq * 8);
#pragma unroll
                    for (int n = 0; n < 4; ++n) {
                        f32x4 acc = (f32x4){0.f, 0.f, 0.f, 0.f};
                        acc = __builtin_amdgcn_mfma_f32_16x16x32_f16(Af[0], Bf[n][0], acc, 0, 0, 0);
                        acc = __builtin_amdgcn_mfma_f32_16x16x32_f16(Af[1], Bf[n][1], acc, 0, 0, 0);
                        const int c = wid * 64 + 16 * n + fr, lb = l0 + 16 * m + 4 * fq;
                        const float adel = 3.070113457325394f + (float)c * ((15.350567286626971f - 3.070113457325394f) / 511.0f);
                        float v[4];
#pragma unroll
                        for (int jj = 0; jj < 4; ++jj) v[jj] = acc[jj] * __expf(-(float)(lb + jj) * (1.0f / (float)(SEQ - 1)) * adel);
                        _Float16* dst = kf + ((size_t)(o * 2 + dir) * 512 + c) * SEQ + lb;
                        uint2 w; w.x = pk_f16(v[0], v[1]); w.y = pk_f16(v[2], v[3]);
                        *(uint2*)dst = w;
                    }
                }
            }
        }
    }
}

typedef float c2 __attribute__((ext_vector_type(2)));
__device__ __forceinline__ c2 mk2(float a, float b) { return (c2){a, b}; }
__device__ __forceinline__ c2 cmulf(c2 a, c2 b) { return a.x * b + a.y * (c2){-b.y, b.x}; }
__device__ __forceinline__ c2 cmulc(c2 a, c2 b) { return a.x * (c2){b.x, -b.y} + a.y * (c2){b.y, b.x}; }
__device__ __forceinline__ constexpr float tw_c(int k) { constexpr float t[16] = {1.000000000f, 0.980785280f, 0.923879533f, 0.831469612f, 0.707106781f, 0.555570233f, 0.382683432f, 0.195090322f, 0.000000000f, -0.195090322f, -0.382683432f, -0.555570233f, -0.707106781f, -0.831469612f, -0.923879533f, -0.980785280f}; return t[k]; }
__device__ __forceinline__ constexpr float tw_s(int k) { constexpr float t[16] = {0.000000000f, 0.195090322f, 0.382683432f, 0.555570233f, 0.707106781f, 0.831469612f, 0.923879533f, 0.980785280f, 1.000000000f, 0.980785280f, 0.923879533f, 0.831469612f, 0.707106781f, 0.555570233f, 0.382683432f, 0.195090322f}; return t[k]; }
__device__ __forceinline__ c2 swp(c2 a) { return __builtin_shufflevector(a, a, 1, 0); }
__device__ __forceinline__ c2 twf(c2 d, int k) {
    const float s = 0.70710678118f;
    if (k == 0) return d;
    if (k == 8) return swp(d) * (c2){1.f, -1.f};
    if (k == 4) return d * s + swp(d) * (c2){s, -s};
    if (k == 12) return d * (-s) + swp(d) * (c2){s, -s};
    return d * tw_c(k) + swp(d) * (c2){tw_s(k), -tw_s(k)};
}
__device__ __forceinline__ c2 twi(c2 d, int k) {
    const float s = 0.70710678118f;
    if (k == 0) return d;
    if (k == 8) return swp(d) * (c2){-1.f, 1.f};
    if (k == 4) return d * s + swp(d) * (c2){-s, s};
    if (k == 12) return d * (-s) + swp(d) * (c2){-s, s};
    return d * tw_c(k) + swp(d) * (c2){-tw_s(k), tw_s(k)};
}
__host__ __device__ constexpr int brev(int q, int bits) { int r = 0; for (int i = 0; i < bits; ++i) r |= ((q >> i) & 1) << (bits - 1 - i); return r; }

template <int R> __device__ __forceinline__ void twpow(c2 w1, c2 (&w)[R]) {
    w[0] = mk2(1.f, 0.f); w[1] = w1; w[2] = cmulf(w1, w1); w[3] = cmulf(w[2], w1); w[4] = cmulf(w[2], w[2]);
    w[8] = cmulf(w[4], w[4]); w[12] = cmulf(w[8], w[4]);
    if (R == 32) { w[16] = cmulf(w[8], w[8]); w[20] = cmulf(w[16], w[4]); w[24] = cmulf(w[16], w[8]); w[28] = cmulf(w[16], w[12]); }
#pragma unroll
    for (int j = 1; j < R / 4; ++j)
#pragma unroll
        for (int i = 1; i < 4; ++i) w[4 * j + i] = cmulf(w[4 * j], w[i]);
}
template <int R, bool ZPAD> __device__ __forceinline__ void dft_dif(c2 (&x)[R]) {
    constexpr int LG = (R == 32) ? 5 : 4;
#pragma unroll
    for (int st = 0; st < LG; ++st) {
        const int h = (R / 2) >> st;
#pragma unroll
        for (int t = 0; t < R / 2; ++t) {
            const int i = t & (h - 1), s = (t >> (LG - 1 - st)) * 2 * h, k = (i * 16) >> (LG - 1 - st);
            const c2 a = x[s + i];
            if (ZPAD && st == 0) { x[s + i + h] = twf(a, k); continue; }
            const c2 b = x[s + i + h];
            x[s + i] = a + b;
            x[s + i + h] = twf(a - b, k);
        }
    }
}
template <int R> __device__ __forceinline__ void dft_dit(c2 (&x)[R]) {
    constexpr int LG = (R == 32) ? 5 : 4;
#pragma unroll
    for (int st = 0; st < LG; ++st) {
        const int h = 1 << st;
#pragma unroll
        for (int t = 0; t < R / 2; ++t) {
            const int i = t & (h - 1), s = (t >> st) * 2 * h, k = (i * 16) >> st;
            const c2 a = x[s + i], b = twi(x[s + i + h], k);
            x[s + i] = a + b;
            x[s + i + h] = a - b;
        }
    }
}

template <bool FULL, class RAW, class LD, class FIN> __device__ __forceinline__ void fft_f1(c2* sm, const float4 wB, LD ld, FIN fin) {
#pragma unroll 1
    for (int jj = 0; jj < 2; ++jj) {
        int j = threadIdx.x + jj * 512; asm volatile("" : "+v"(j));
        RAW raw[FULL ? 16 : 8];
#pragma unroll
        for (int r = 0; r < (FULL ? 16 : 8); ++r) raw[r] = ld(j + r * 1024);
        c2 x[16];
#pragma unroll
        for (int r = 0; r < 16; ++r) { if (FULL || r < 8) { const float2 f = fin(raw[r < (FULL ? 16 : 8) ? r : 0], j + r * 1024); x[r] = mk2(f.x, f.y); } else x[r] = mk2(0.f, 0.f); }
        dft_dif<16, !FULL>(x);
        float wx = jj ? wB.z : wB.x, wy = jj ? wB.w : wB.y; asm volatile("" : "+v"(wx), "+v"(wy));
        c2 w[16]; twpow<16>(mk2(wx, wy), w);
        const int base = j + (j >> 5);
        sm[base] = x[0];
#pragma unroll
        for (int q = 1; q < 16; ++q) sm[base + q * 1056] = cmulf(x[brev(q, 4)], w[q]);
    }
}
typedef _Float16 h2_t __attribute__((ext_vector_type(2)));
__device__ __forceinline__ void fft_build_ctab(uint4* ctab) {
    for (int e = threadIdx.x; e < 1024; e += NTHREADS) {
        const int inv = e >> 9, mt = (e >> 7) & 3, s = (e >> 6) & 1, lane = e & 63, m = lane & 15, kq = lane >> 4, r = 16 * (mt & 1) + m;
        float v[8];
#pragma unroll
        for (int i = 0; i < 8; ++i) {
            const int k = inv ? (16 * (i >> 2) + 4 * kq + (i & 3)) : (8 * kq + i);
            float sn, cs; sincospif((float)((r * k) & 31) * (1.0f / 16.0f), &sn, &cs);
            if (!inv) v[i] = 0.25f * ((mt < 2) ? (s == 0 ? cs : sn) : (s == 0 ? -sn : cs));
            else      v[i] = 0.0625f * ((mt < 2) ? (s == 0 ? cs : -sn) : (s == 0 ? sn : cs));
        }
        uint4 w; w.x = pk_f16(v[0], v[1]); w.y = pk_f16(v[2], v[3]); w.z = pk_f16(v[4], v[5]); w.w = pk_f16(v[6], v[7]);
        ctab[e] = w;
    }
}
__device__ __forceinline__ f16x8 cvt8(float a0, float a1, float a2, float a3, float a4, float a5, float a6, float a7) {
    u32x4 w; w.x = pk_f16(a0, a1); w.y = pk_f16(a2, a3); w.z = pk_f16(a4, a5); w.w = pk_f16(a6, a7); return __builtin_bit_cast(f16x8, w);
}
template <bool FILTER> __device__ __forceinline__ void fft_f3_mfma(c2* sm, unsigned* __restrict__ K) {
    const int lane = threadIdx.x & 63, n = lane & 15, kq = lane >> 4;
    const uint4* ctab = (const uint4*)(sm + FN + 512);
    unsigned koff = threadIdx.x; asm volatile("" : "+v"(koff)); unsigned* Kp = K + koff;
    unsigned kr[32];
    if (!FILTER) {
#pragma unroll
        for (int r = 0; r < 32; ++r) kr[r] = Kp[r * 512];
    }
    f16x8 Af[4][2], Ai[4][2];
#pragma unroll
    for (int mt = 0; mt < 4; ++mt)
#pragma unroll
        for (int s = 0; s < 2; ++s) {
            Af[mt][s] = __builtin_bit_cast(f16x8, ctab[(mt * 2 + s) * 64 + lane]);
            if (!FILTER) Ai[mt][s] = __builtin_bit_cast(f16x8, ctab[512 + (mt * 2 + s) * 64 + lane]);
        }
#pragma unroll
    for (int g = 0; g < 4; ++g) {
        const int base = ((threadIdx.x & ~63) + g * 16 + n) * 33;
        c2 e[8];
#pragma unroll
        for (int i = 0; i < 8; ++i) e[i] = sm[base + 8 * kq + i];
        const f16x8 Bre = cvt8(e[0].x, e[1].x, e[2].x, e[3].x, e[4].x, e[5].x, e[6].x, e[7].x);
        const f16x8 Bim = cvt8(e[0].y, e[1].y, e[2].y, e[3].y, e[4].y, e[5].y, e[6].y, e[7].y);
        f32x4 D[4];
        __builtin_amdgcn_s_setprio(1);
#pragma unroll
        for (int mt = 0; mt < 4; ++mt) {
            D[mt] = __builtin_amdgcn_mfma_f32_16x16x32_f16(Af[mt][0], Bre, (f32x4){0.f, 0.f, 0.f, 0.f}, 0, 0, 0);
            D[mt] = __builtin_amdgcn_mfma_f32_16x16x32_f16(Af[mt][1], Bim, D[mt], 0, 0, 0);
        }
        __builtin_amdgcn_s_setprio(0);
        if (FILTER) {
#pragma unroll
            for (int t = 0; t < 2; ++t)
#pragma unroll
                for (int jj = 0; jj < 4; ++jj) Kp[(g * 8 + t * 4 + jj) * 512] = pk_f16(D[t][jj] * (1.0f / 2048.0f), D[t + 2][jj] * (1.0f / 2048.0f));
        } else {
            float yr[8], yi[8];
#pragma unroll
            for (int t = 0; t < 2; ++t)
#pragma unroll
                for (int jj = 0; jj < 4; ++jj) {
                    const h2_t h = __builtin_bit_cast(h2_t, kr[g * 8 + t * 4 + jj]);
                    const c2 y = cmulf(mk2(D[t][jj], D[t + 2][jj]), mk2((float)h.x, (float)h.y));
                    yr[t * 4 + jj] = y.x; yi[t * 4 + jj] = y.y;
                }
            const f16x8 Cre = cvt8(yr[0], yr[1], yr[2], yr[3], yr[4], yr[5], yr[6], yr[7]);
            const f16x8 Cim = cvt8(yi[0], yi[1], yi[2], yi[3], yi[4], yi[5], yi[6], yi[7]);
            f32x4 E[4];
#pragma unroll
            for (int mt = 0; mt < 4; ++mt) {
                E[mt] = __builtin_amdgcn_mfma_f32_16x16x32_f16(Ai[mt][0], Cre, (f32x4){0.f, 0.f, 0.f, 0.f}, 0, 0, 0);
                E[mt] = __builtin_amdgcn_mfma_f32_16x16x32_f16(Ai[mt][1], Cim, E[mt], 0, 0, 0);
            }
#pragma unroll
            for (int t = 0; t < 2; ++t)
#pragma unroll
                for (int jj = 0; jj < 4; ++jj) sm[base + 16 * t + 4 * kq + jj] = mk2(E[t][jj], E[t + 2][jj]);
        }
    }
}
__device__ __forceinline__ void fft_f3_mfma_pack(c2* sm, unsigned* __restrict__ K0, unsigned* __restrict__ K1) {
    const int lane = threadIdx.x & 63, n = lane & 15, kq = lane >> 4;
    const uint4* ctab = (const uint4*)(sm + FN + 512);
    f16x8 Af[4][2];
#pragma unroll
    for (int mt = 0; mt < 4; ++mt)
#pragma unroll
        for (int s = 0; s < 2; ++s) Af[mt][s] = __builtin_bit_cast(f16x8, ctab[(mt * 2 + s) * 64 + lane]);
#pragma unroll
    for (int g = 0; g < 4; ++g) {
        const int base = ((threadIdx.x & ~63) + g * 16 + n) * 33;
        c2 e[8];
#pragma unroll
        for (int i = 0; i < 8; ++i) e[i] = sm[base + 8 * kq + i];
        const f16x8 Bre = cvt8(e[0].x, e[1].x, e[2].x, e[3].x, e[4].x, e[5].x, e[6].x, e[7].x);
        const f16x8 Bim = cvt8(e[0].y, e[1].y, e[2].y, e[3].y, e[4].y, e[5].y, e[6].y, e[7].y);
        f32x4 D[4];
        __builtin_amdgcn_s_setprio(1);
#pragma unroll
        for (int mt = 0; mt < 4; ++mt) {
            D[mt] = __builtin_amdgcn_mfma_f32_16x16x32_f16(Af[mt][0], Bre, (f32x4){0.f, 0.f, 0.f, 0.f}, 0, 0, 0);
            D[mt] = __builtin_amdgcn_mfma_f32_16x16x32_f16(Af[mt][1], Bim, D[mt], 0, 0, 0);
        }
        __builtin_amdgcn_s_setprio(0);
#pragma unroll
        for (int t = 0; t < 2; ++t)
#pragma unroll
            for (int jj = 0; jj < 4; ++jj) sm[base + 16 * t + 4 * kq + jj] = mk2(D[t][jj], D[t + 2][jj]);
    }
    __syncthreads();
    unsigned koff = threadIdx.x; asm volatile("" : "+v"(koff)); unsigned* Kp0 = K0 + koff; unsigned* Kp1 = K1 + koff;
#pragma unroll 1
    for (int g = 0; g < 4; ++g) {
        const int rho = (threadIdx.x & ~63) + g * 16 + n;
#pragma unroll
        for (int t = 0; t < 2; ++t)
#pragma unroll
            for (int jj = 0; jj < 4; ++jj) {
                const int m = 16 * t + 4 * kq + jj;
                const int f = (rho >> 5) + 16 * (rho & 31) + 512 * m, fp = (FN - f) & (FN - 1);
                const int rp = 32 * (fp & 15) + ((fp >> 4) & 31), mp = fp >> 9;
                const c2 zf = sm[rho * 33 + m], zp = sm[rp * 33 + mp];
                const float s = 0.5f * 16.0f / 2048.0f;
                Kp0[(g * 8 + t * 4 + jj) * 512] = pk_f16((zf.x + zp.x) * s, (zf.y - zp.y) * s);
                Kp1[(g * 8 + t * 4 + jj) * 512] = pk_f16((zf.y + zp.y) * s, (zp.x - zf.x) * s);
            }
    }
}
__device__ __forceinline__ void fft_twinv_build(float* tvl) {
    if (threadIdx.x < 64) {
        const int lane = threadIdx.x, n = lane & 15, kq = lane >> 4;
#pragma unroll
        for (int p = 0; p < 2; ++p) {
            const int j = 16 * p + n; float sn, cs;
            sincospif((float)(j & 1023) * (1.0f / 512.0f), &sn, &cs); tvl[(0 + p) * 64 + lane] = cs; tvl[(2 + p) * 64 + lane] = -sn;
            sincospif((float)((4 * kq * j) & 1023) * (1.0f / 512.0f), &sn, &cs); tvl[(4 + p) * 64 + lane] = cs; tvl[(6 + p) * 64 + lane] = -sn;
            sincospif((float)((16 * j) & 1023) * (1.0f / 512.0f), &sn, &cs); tvl[(8 + p) * 64 + lane] = cs; tvl[(10 + p) * 64 + lane] = -sn;
        }
    }
}
template <bool INV> __device__ __forceinline__ void fft_p2_mfma(c2* sm, const float* tv) {
    const int lane = threadIdx.x & 63, n = lane & 15, kq = lane >> 4;
    const uint4* ctab = (const uint4*)(sm + FN + 512);
    f16x8 Am[4][2];
#pragma unroll
    for (int mt = 0; mt < 4; ++mt)
#pragma unroll
        for (int s = 0; s < 2; ++s) Am[mt][s] = __builtin_bit_cast(f16x8, ctab[(INV ? 512 : 0) + (mt * 2 + s) * 64 + lane]);
#pragma unroll
    for (int g = 0; g < 4; ++g) {
        const int bf = (threadIdx.x & ~63) + g * 16 + n, base = (bf >> 5) * 1056 + (bf & 31);
        const int p_ = g & 1;
        const float ax = tv[(0 + p_) * 64 + lane], ay = tv[(2 + p_) * 64 + lane], bx = tv[(4 + p_) * 64 + lane], by = tv[(6 + p_) * 64 + lane], cx = tv[(8 + p_) * 64 + lane], cy = tv[(10 + p_) * 64 + lane];
        const c2 w1 = mk2(ax, ay), wk = mk2(bx, by), w16 = mk2(cx, cy);
        c2 tw[8];
        { const c2 w2 = cmulf(w1, w1), w3 = cmulf(w2, w1);
          tw[0] = wk; tw[1] = cmulf(wk, w1); tw[2] = cmulf(wk, w2); tw[3] = cmulf(wk, w3);
#pragma unroll
          for (int jj = 0; jj < 4; ++jj) tw[4 + jj] = cmulf(tw[jj], w16); }
        c2 e[8];
        if (!INV) {
#pragma unroll
            for (int i = 0; i < 8; ++i) e[i] = sm[base + (8 * kq + i) * 33];
        } else {
#pragma unroll
            for (int i = 0; i < 8; ++i) e[i] = cmulc(sm[base + (16 * (i >> 2) + 4 * kq + (i & 3)) * 33], tw[i]);
        }
        const f16x8 Bre = cvt8(e[0].x, e[1].x, e[2].x, e[3].x, e[4].x, e[5].x, e[6].x, e[7].x);
        const f16x8 Bim = cvt8(e[0].y, e[1].y, e[2].y, e[3].y, e[4].y, e[5].y, e[6].y, e[7].y);
        f32x4 D[4];
        __builtin_amdgcn_s_setprio(1);
#pragma unroll
        for (int mt = 0; mt < 4; ++mt) {
            D[mt] = __builtin_amdgcn_mfma_f32_16x16x32_f16(Am[mt][0], Bre, (f32x4){0.f, 0.f, 0.f, 0.f}, 0, 0, 0);
            D[mt] = __builtin_amdgcn_mfma_f32_16x16x32_f16(Am[mt][1], Bim, D[mt], 0, 0, 0);
        }
        __builtin_amdgcn_s_setprio(0);
#pragma unroll
        for (int t = 0; t < 2; ++t)
#pragma unroll
            for (int jj = 0; jj < 4; ++jj) {
                const c2 v = mk2(D[t][jj], D[t + 2][jj]);
                sm[base + (16 * t + 4 * kq + jj) * 33] = INV ? v : cmulf(v, tw[t * 4 + jj]);
            }
    }
}
__device__ __forceinline__ uint2 ldwin(const bf16_t* __restrict__ row, int l) { return *(const uint2*)(row + (int)((unsigned)(l - 1) & ~1u)); }
__device__ __forceinline__ float sconv_w(uint2 wv, int l, float w0, float w1, float w2, float b) {
    float a, m, n;
    if (l & 1) { a = __uint_as_float(wv.x << 16); m = __uint_as_float(wv.x & 0xffff0000u); n = __uint_as_float(wv.y << 16); }
    else       { a = __uint_as_float(wv.x & 0xffff0000u); m = __uint_as_float(wv.y << 16); n = __uint_as_float(wv.y & 0xffff0000u); }
    a = l > 0 ? a : 0.f; n = l < SEQ - 1 ? n : 0.f;
    return a * w0 + m * w1 + n * w2 + b;
}
template <bool FUSE_F1, class RAW, class GL, class GF, class EP> __device__ __forceinline__ void fft_i1(c2* sm, const float4 wB, GL gl, GF gf, EP ep) {
#pragma unroll 1
    for (int jj = 0; jj < 2; ++jj) {
        int j = threadIdx.x + jj * 512; asm volatile("" : "+v"(j));
        RAW raw[8];
#pragma unroll
        for (int r = 0; r < 8; ++r) raw[r] = gl(j + r * 1024);
        float wx = jj ? wB.z : wB.x, wy = jj ? wB.w : wB.y; asm volatile("" : "+v"(wx), "+v"(wy));
        c2 w[16]; twpow<16>(mk2(wx, wy), w);
        const int base = j + (j >> 5);
        c2 x[16];
        x[0] = sm[base];
#pragma unroll
        for (int q = 1; q < 16; ++q) x[brev(q, 4)] = cmulc(sm[base + q * 1056], w[q]);
        dft_dit<16>(x);
#pragma unroll
        for (int r = 0; r < 8; ++r) { const float2 g = gf(raw[r], j + r * 1024); x[r] = x[r] * mk2(g.x, g.y); }
        if (FUSE_F1) {
#pragma unroll
            for (int r = 8; r < 16; ++r) x[r] = mk2(0.f, 0.f);
            dft_dif<16, true>(x);
            sm[base] = x[0];
#pragma unroll
            for (int q = 1; q < 16; ++q) sm[base + q * 1056] = cmulf(x[brev(q, 4)], w[q]);
        } else {
#pragma unroll
            for (int r = 0; r < 8; ++r) ep(j + r * 1024, make_float2(x[r].x, x[r].y));
        }
    }
}

struct G2Raw { uint2 p0, p1; bf16_t z0, z1; };
#define SYNC_SB() do { __syncthreads(); __builtin_amdgcn_sched_barrier(0); } while (0)
#define WAVE_SB() do { __builtin_amdgcn_fence(__ATOMIC_RELEASE, "wavefront"); __builtin_amdgcn_wave_barrier(); __builtin_amdgcn_fence(__ATOMIC_ACQUIRE, "wavefront"); __builtin_amdgcn_sched_barrier(0); } while (0)
__device__ __forceinline__ void ph_fftconv(const Params& p, float2* sm_) {
    c2* sm = reinterpret_cast<c2*>(sm_);
    const bf16_t* pT = (const bf16_t*)(p.ws + WS_PT);
    const _Float16* kf = (const _Float16*)(p.ws + WS_KF);
    bf16_t* gT = (bf16_t*)(p.ws + WS_GT);
    unsigned* K0 = (unsigned*)(p.ws + WS_KS) + (size_t)blockIdx.x * 2 * FN; unsigned* K1 = K0 + FN;
    const float* conv_w = p.in[3]; const float* conv_b = p.in[4]; const float* hd = p.in[13];
    float4 wB;
    { float sn, cs;
      sincospif((float)threadIdx.x * (1.0f / 8192.0f), &sn, &cs); wB.x = cs; wB.y = -sn;
      sincospif((float)(threadIdx.x + 512) * (1.0f / 8192.0f), &sn, &cs); wB.z = cs; wB.w = -sn; }
    const float kscale = 16.0f * 256.0f * 2048.0f / (float)FN;
    fft_build_ctab((uint4*)(sm + FN + 512));
    float* tv = (float*)((unsigned char*)sm_ + 151552);
    fft_twinv_build(tv);
    __syncthreads();
    for (int c = blockIdx.x; c < HWD; c += gridDim.x) {
        {
            const _Float16* kf0 = kf + ((size_t)0 * 512 + c) * SEQ; const _Float16* kb0 = kf + ((size_t)1 * 512 + c) * SEQ;
            const _Float16* kf1 = kf + ((size_t)2 * 512 + c) * SEQ; const _Float16* kb1 = kf + ((size_t)3 * 512 + c) * SEQ;
            const float d0 = hd[c], d1 = hd[512 + c];
            fft_f1<true, h2_t>(sm, wB, [&](int i) -> h2_t { const int ib = (i == SEQ) ? 1 : 2 * SEQ - i; h2_t v; v.x = i < SEQ ? kf0[i] : kb0[ib]; v.y = i < SEQ ? kf1[i] : kb1[ib]; return v; },
                [&](h2_t v, int i) -> float2 { return i == SEQ ? make_float2(0.f, 0.f) : make_float2((float)v.x + (i == 0 ? d0 : 0.f), (float)v.y + (i == 0 ? d1 : 0.f)); });
            SYNC_SB(); fft_p2_mfma<false>(sm, tv); WAVE_SB(); fft_f3_mfma_pack(sm, K0, K1); SYNC_SB();
        }
        const bf16_t* r0 = pT + (size_t)c * NTOK; const bf16_t* r1 = pT + (size_t)(512 + c) * NTOK; const bf16_t* r2 = pT + (size_t)(1024 + c) * NTOK; const bf16_t* r3 = pT + (size_t)(1536 + c) * NTOK;
        const float a0 = conv_w[c], a1 = conv_w[1536 + c], a2 = conv_w[3072 + c], ab = conv_b[c];
        const float b0 = conv_w[512 + c] * kscale, b1 = conv_w[1536 + 512 + c] * kscale, b2 = conv_w[3072 + 512 + c] * kscale, bb = conv_b[512 + c] * kscale;
        const float c0 = conv_w[1024 + c] * kscale, c1 = conv_w[1536 + 1024 + c] * kscale, c2 = conv_w[3072 + 1024 + c] * kscale, cb = conv_b[1024 + c] * kscale;
        bf16_t* grow = gT + (size_t)c * NTOK;
#pragma unroll 1
        for (int pair = 0; pair < 2; ++pair) {
            const int t0 = pair * 2 * SEQ;
            fft_f1<false, uint4>(sm, wB, [&](int l) -> uint4 { const uint2 p0 = ldwin(r0 + t0, l), p1 = ldwin(r0 + t0 + SEQ, l); return make_uint4(p0.x, p0.y, p1.x, p1.y); },
                [&](uint4 v, int l) -> float2 { return make_float2(sconv_w(make_uint2(v.x, v.y), l, a0, a1, a2, ab), sconv_w(make_uint2(v.z, v.w), l, a0, a1, a2, ab)); });
            SYNC_SB(); fft_p2_mfma<false>(sm, tv); WAVE_SB(); fft_f3_mfma<false>(sm, K0); WAVE_SB(); fft_p2_mfma<true>(sm, tv); SYNC_SB();
            fft_i1<true, uint4>(sm, wB, [&](int l) -> uint4 { const uint2 p0 = ldwin(r1 + t0, l), p1 = ldwin(r1 + t0 + SEQ, l); return make_uint4(p0.x, p0.y, p1.x, p1.y); },
                [&](uint4 v, int l) -> float2 { return make_float2(sconv_w(make_uint2(v.x, v.y), l, b0, b1, b2, bb), sconv_w(make_uint2(v.z, v.w), l, b0, b1, b2, bb)); }, [&](int, float2) {});
            SYNC_SB(); fft_p2_mfma<false>(sm, tv); WAVE_SB(); fft_f3_mfma<false>(sm, K1); WAVE_SB(); fft_p2_mfma<true>(sm, tv); SYNC_SB();
            fft_i1<false, G2Raw>(sm, wB, [&](int l) -> G2Raw { G2Raw q; q.p0 = ldwin(r2 + t0, l); q.p1 = ldwin(r2 + t0 + SEQ, l); q.z0 = r3[t0 + l]; q.z1 = r3[t0 + SEQ + l]; return q; },
                [&](G2Raw v, int l) -> float2 { return make_float2(sconv_w(v.p0, l, c0, c1, c2, cb) * silu(bf2f(v.z0)), sconv_w(v.p1, l, c0, c1, c2, cb) * silu(bf2f(v.z1))); },
                [&](int l, float2 v) { grow[t0 + l] = f2bf(v.x); grow[t0 + SEQ + l] = f2bf(v.y); });
        }
    }
}

template <int HW> __device__ __forceinline__ void pool_rows(const bf16_t* __restrict__ us, bf16_t* __restrict__ pa, int cp, int th, int l0) {
    const bf16_t* col = us + 2 * cp;
    const int tb = th * 32;
    float s0 = 0.f, s1 = 0.f; int cnt = 0;
#pragma unroll
    for (int k = 0; k < 2 * HW; ++k) {
        const int q = l0 + tb - HW + k; const bool ok = (q >= 0) && (q < SEQ);
        const unsigned v = *(const unsigned*)(col + (tb + 8 - HW + k) * 512);
        s0 += ok ? __uint_as_float(v << 16) : 0.f; s1 += ok ? __uint_as_float(v & 0xffff0000u) : 0.f; cnt += ok ? 1 : 0;
    }
#pragma unroll 4
    for (int tt = 0; tt < 32; ++tt) {
        const int t = tb + tt, l = l0 + t;
        const unsigned cv = *(const unsigned*)(col + (t + 8) * 512);
        const float inv = 1.0f / (float)cnt;
        *(unsigned*)(pa + t * 520 + 2 * cp) = cvt_pk_bf16(s0 * inv - __uint_as_float(cv << 16), s1 * inv - __uint_as_float(cv & 0xffff0000u));
        if (tt < 31) {
            const unsigned va = *(const unsigned*)(col + (t + 8 + HW) * 512), vd = *(const unsigned*)(col + (t + 8 - HW) * 512);
            const bool oka = (l + HW) < SEQ, okd = (l - HW) >= 0;
            s0 += (oka ? __uint_as_float(va << 16) : 0.f) - (okd ? __uint_as_float(vd << 16) : 0.f);
            s1 += (oka ? __uint_as_float(va & 0xffff0000u) : 0.f) - (okd ? __uint_as_float(vd & 0xffff0000u) : 0.f);
            cnt += (oka ? 1 : 0) - (okd ? 1 : 0);
        }
    }
}

__device__ __forceinline__ void ph_mix(const Params& p, unsigned char* smem) {
    bf16_t* gs = (bf16_t*)smem;
    bf16_t* pa = (bf16_t*)smem;
    bf16_t* us = (bf16_t*)(smem + 67584);
    float* part = (float*)(smem + 67584 + 81920);
    float* rs = part + 512;
    const bf16_t* gT = (const bf16_t*)(p.ws + WS_GT);
    const bf16_t* pR = (const bf16_t*)(p.ws + WS_PR);
    const bf16_t* PWt = (const bf16_t*)(p.ws + WS_PWT);
    bf16_t* A2 = (bf16_t*)(p.ws + WS_A2);
    const float* pscale = p.in[15]; const float* nhg = p.in[16]; const float* npg = p.in[17];
    const int tid = threadIdx.x, lane = tid & 63, wid = tid >> 6, fr = lane & 15, fq = lane >> 4;
    for (int tile = blockIdx.x; tile < NTOK / 64; tile += gridDim.x) {
        const int tok0 = tile * 64, batch = tok0 / SEQ, l0 = tok0 % SEQ;
        __syncthreads();
        {
            u32x4 gv[8], uv[10];
#pragma unroll
            for (int k = 0; k < 8; ++k) { const int i = tid + k * NTHREADS, c = i >> 3, ch = i & 7; gv[k] = *(const u32x4*)(gT + (size_t)c * NTOK + tok0 + ch * 8); }
#pragma unroll
            for (int k = 0; k < 10; ++k) {
                const int i = tid + k * NTHREADS, r = i >> 6, ch = i & 63; int l = l0 - 8 + r; l = l < 0 ? 0 : (l > SEQ - 1 ? SEQ - 1 : l);
                uv[k] = *(const u32x4*)(pR + (size_t)(batch * SEQ + l) * 1024 + ch * 8);
            }
#pragma unroll
            for (int k = 0; k < 8; ++k) { const int i = tid + k * NTHREADS, c = i >> 3, ch = i & 7; unsigned* d = (unsigned*)(gs + c * 66 + ch * 8); d[0] = gv[k].x; d[1] = gv[k].y; d[2] = gv[k].z; d[3] = gv[k].w; }
#pragma unroll
            for (int k = 0; k < 10; ++k) { const int i = tid + k * NTHREADS, r = i >> 6, ch = i & 63; *(u32x4*)(us + r * 512 + ch * 8) = uv[k]; }
        }
        __syncthreads();
        {
            const int tok = tid & 63, cgp = tid >> 6; float s = 0.f;
#pragma unroll 16
            for (int cc = 0; cc < 64; ++cc) { const float v = bf2f(gs[(cgp * 64 + cc) * 66 + tok]); s += v * v; }
            part[cgp * 64 + tok] = s;
        }
        __syncthreads();
        if (tid < 64) { float s = 0.f; for (int g = 0; g < 8; ++g) s += part[g * 64 + tid]; rs[tid] = rsqrtf(s * (1.0f / 512.0f) + 1e-6f); }
        __syncthreads();
        {
            const int tok = wid * 8 + (lane >> 3), cseg = lane & 7; const float r = rs[tok];
#pragma unroll
            for (int j = 0; j < 8; ++j) {
                const int c0 = (cseg + 8 * j) * 8;
                const f32x4 ga = *(const f32x4*)(nhg + c0), gb = *(const f32x4*)(nhg + c0 + 4);
                float v[8];
#pragma unroll
                for (int i = 0; i < 8; ++i) v[i] = bf2f(gs[(c0 + i) * 66 + tok]) * r;
                u32x4 w; w.x = cvt_pk_bf16(v[0] * ga[0], v[1] * ga[1]); w.y = cvt_pk_bf16(v[2] * ga[2], v[3] * ga[3]); w.z = cvt_pk_bf16(v[4] * gb[0], v[5] * gb[1]); w.w = cvt_pk_bf16(v[6] * gb[2], v[7] * gb[3]);
                *(u32x4*)(A2 + (size_t)(tok0 + tok) * 1024 + c0) = w;
            }
        }
        __syncthreads();
        {
            const int cp = tid & 255, th = tid >> 8, g = cp >> 6;
            if (g == 0) pool_rows<1>(us, pa, cp, th, l0);
            else if (g == 1) pool_rows<2>(us, pa, cp, th, l0);
            else if (g == 2) pool_rows<4>(us, pa, cp, th, l0);
            else pool_rows<8>(us, pa, cp, th, l0);
        }
        __syncthreads();
        {
            const int g = wid >> 1, nh = wid & 1;
            f32x4 acc[4][4];
#pragma unroll
            for (int m = 0; m < 4; ++m)
#pragma unroll
                for (int n = 0; n < 4; ++n) acc[m][n] = (f32x4){0.f, 0.f, 0.f, 0.f};
#pragma unroll
            for (int kk = 0; kk < 4; ++kk) {
                bf16x8 Af[4], Bf[4];
#pragma unroll
                for (int m = 0; m < 4; ++m) Af[m] = *(const bf16x8*)(pa + (16 * m + fr) * 520 + g * 128 + kk * 32 + fq * 8);
#pragma unroll
                for (int n = 0; n < 4; ++n) Bf[n] = *(const bf16x8*)(PWt + g * 16384 + (nh * 64 + 16 * (fr >> 2) + 4 * n + (fr & 3)) * 128 + kk * 32 + fq * 8);
#pragma unroll
                for (int m = 0; m < 4; ++m)
#pragma unroll
                    for (int n = 0; n < 4; ++n) acc[m][n] = __builtin_amdgcn_mfma_f32_16x16x32_bf16(Bf[n], Af[m], acc[m][n], 0, 0, 0);
            }
            float ssq[4];
#pragma unroll
            for (int m = 0; m < 4; ++m) {
                const int t = 16 * m + fr; float s = 0.f;
                const int dbase = g * 128 + nh * 64 + 16 * fq;
                const u32x4 zq0 = *(const u32x4*)(pR + (size_t)(tok0 + t) * 1024 + 512 + dbase), zq1 = *(const u32x4*)(pR + (size_t)(tok0 + t) * 1024 + 512 + dbase + 8);
#pragma unroll
                for (int n = 0; n < 4; ++n) {
                    const int dch = dbase + 4 * n;
                    uint2 zz; zz.x = (n < 2 ? zq0 : zq1)[2 * (n & 1)]; zz.y = (n < 2 ? zq0 : zq1)[2 * (n & 1) + 1];
                    const f32x4 ps = *(const f32x4*)(pscale + dch);
                    const float z0 = __uint_as_float(zz.x << 16), z1 = __uint_as_float(zz.x & 0xffff0000u), z2 = __uint_as_float(zz.y << 16), z3 = __uint_as_float(zz.y & 0xffff0000u);
                    f32x4 v = acc[m][n];
                    v[0] = v[0] * ps[0] * silu(z0); v[1] = v[1] * ps[1] * silu(z1); v[2] = v[2] * ps[2] * silu(z2); v[3] = v[3] * ps[3] * silu(z3);
                    acc[m][n] = v;
                    s += v[0] * v[0] + v[1] * v[1] + v[2] * v[2] + v[3] * v[3];
                }
                s += __shfl_xor(s, 16); s += __shfl_xor(s, 32);
                ssq[m] = s;
            }
            if (fq == 0) {
#pragma unroll
                for (int m = 0; m < 4; ++m) part[wid * 64 + 16 * m + fr] = ssq[m];
            }
            __syncthreads();
            if (tid < 64) { float s = 0.f; for (int w = 0; w < 8; ++w) s += part[w * 64 + tid]; rs[tid] = rsqrtf(s * (1.0f / 512.0f) + 1e-6f); }
            __syncthreads();
#pragma unroll
            for (int m = 0; m < 4; ++m) {
                const int t = 16 * m + fr; const float r = rs[t];
                const int dbase = g * 128 + nh * 64 + 16 * fq;
                unsigned wv[8];
#pragma unroll
                for (int n = 0; n < 4; ++n) {
                    const f32x4 ng = *(const f32x4*)(npg + dbase + 4 * n);
                    const f32x4 v = acc[m][n];
                    wv[2 * n] = cvt_pk_bf16(v[0] * r * ng[0], v[1] * r * ng[1]); wv[2 * n + 1] = cvt_pk_bf16(v[2] * r * ng[2], v[3] * r * ng[3]);
                }
                *(u32x4*)(A2 + (size_t)(tok0 + t) * 1024 + 512 + dbase) = (u32x4){wv[0], wv[1], wv[2], wv[3]};
                *(u32x4*)(A2 + (size_t)(tok0 + t) * 1024 + 512 + dbase + 8) = (u32x4){wv[4], wv[5], wv[6], wv[7]};
            }
        }
    }
}

__device__ __forceinline__ void ph_final(const Params& p) {
    const float* __restrict__ x = p.in[0]; const float* __restrict__ pg = p.in[19];
    const bf16_t* __restrict__ ob = (const bf16_t*)(p.ws + WS_OUTB);
    float* __restrict__ out = p.out;
    const int lane = threadIdx.x & 63, wid = threadIdx.x >> 6;
    float4 g4[4];
#pragma unroll
    for (int h = 0; h < 2; ++h) { g4[2 * h] = ((const float4*)pg)[128 * h + lane * 2]; g4[2 * h + 1] = ((const float4*)pg)[128 * h + lane * 2 + 1]; }
    for (int row = blockIdx.x * 8 + wid; row < NTOK; row += gridDim.x * 8) {
        const float4* xr = (const float4*)(x + (size_t)row * DM);
        float4 xv[4]; u32x4 ov[2];
#pragma unroll
        for (int h = 0; h < 2; ++h) { ov[h] = *(const u32x4*)(ob + (size_t)row * DM + 512 * h + lane * 8); xv[2 * h] = xr[128 * h + lane * 2]; xv[2 * h + 1] = xr[128 * h + lane * 2 + 1]; }
        float o[16]; float ss = 0.f;
#pragma unroll
        for (int h = 0; h < 2; ++h)
#pragma unroll
            for (int e = 0; e < 4; ++e) { const unsigned w = ov[h][e]; o[h * 8 + 2 * e] = __uint_as_float(w << 16); o[h * 8 + 2 * e + 1] = __uint_as_float(w & 0xffff0000u); }
#pragma unroll
        for (int e = 0; e < 16; ++e) ss += o[e] * o[e];
        ss = wave_sum(ss);
        const float r = rsqrtf(ss * (1.0f / DM) + 1e-6f);
#pragma unroll
        for (int q = 0; q < 4; ++q) {
            float4 y;
            y.x = xv[q].x + o[q * 4 + 0] * r * g4[q].x; y.y = xv[q].y + o[q * 4 + 1] * r * g4[q].y; y.z = xv[q].z + o[q * 4 + 2] * r * g4[q].z; y.w = xv[q].w + o[q * 4 + 3] * r * g4[q].w;
            ((float4*)(out + (size_t)row * DM))[128 * (q >> 1) + lane * 2 + (q & 1)] = y;
        }
    }
}

#define XB_TMO      128
#define XB_XCNT(j)  (256  + 64 * (j))
#define XB_XSUB(j)  (1280 + 64 * (j))
#define XB_XGEN(j)  (2304 + 64 * (j))
#define XB_TOP      3328
#define XB_TOPGEN   3392
#define XCD_BAR_WORDS 3456
#define XB_SPIN_CAP (1u << 18)
#define LAS __attribute__((address_space(3)))

__device__ __forceinline__ unsigned xb_ld(unsigned* p)              { return __hip_atomic_load(p, __ATOMIC_RELAXED, __HIP_MEMORY_SCOPE_AGENT); }
__device__ __forceinline__ unsigned xb_add(unsigned* p, unsigned v) { return __hip_atomic_fetch_add(p, v, __ATOMIC_RELAXED, __HIP_MEMORY_SCOPE_AGENT); }
__device__ __forceinline__ unsigned xb_xcc_id() { return (unsigned)__builtin_amdgcn_s_getreg((3 << 11) | 20) & 0xFu; }
#define XB_SPIN(cond, bar) do { unsigned _sp = 0; while (cond) { __builtin_amdgcn_s_sleep(1); \
    if ((++_sp & 255u) == 0u) { if (xb_ld(&(bar)[XB_TMO])) break; if (_sp > XB_SPIN_CAP) { atomicAdd(&(bar)[XB_TMO], 1u); break; } } } } while (0)

struct XcdBarrier {
    unsigned* bar; unsigned x;
    volatile LAS unsigned* st;
};

__device__ __forceinline__ XcdBarrier xcd_barrier_post(unsigned* bar, volatile LAS unsigned* st) {
    XcdBarrier b; b.bar = bar; b.x = xb_xcc_id(); b.st = st;
    if (threadIdx.x == 0) (void)xb_add(&bar[XB_XCNT(b.x)], 1u);
    return b;
}
__device__ __forceinline__ void xcd_barrier_complete(unsigned* bar, unsigned x, unsigned& nloc, unsigned& nx) {
    const unsigned G = gridDim.x * gridDim.y * gridDim.z;
    unsigned sum, cnt, mine, sp = 0u;
    for (;;) {
        sum = 0u; cnt = 0u; mine = 0u;
#pragma unroll
        for (unsigned j = 0; j < 16; ++j) { const unsigned c = xb_ld(&bar[XB_XCNT(j)]); sum += c; cnt += (c > 0u) ? 1u : 0u; mine = (j == x) ? c : mine; }
        if (sum == G) break;
        __builtin_amdgcn_s_sleep(1);
        if ((++sp & 255u) == 0u) { if (xb_ld(&bar[XB_TMO])) break; if (sp > XB_SPIN_CAP) { atomicAdd(&bar[XB_TMO], 1u); break; } }
    }
    nloc = mine > 0u ? mine : 1u; nx = cnt > 0u ? cnt : 1u;
}

__device__ __forceinline__ void xcd_barrier(const XcdBarrier& b) {
    asm volatile("s_waitcnt vmcnt(0)" ::: "memory");
    __syncthreads();
    if (threadIdx.x == 0) {
        unsigned* bar = b.bar;
        __builtin_amdgcn_s_waitcnt(0);
        unsigned nloc = b.st[0], nx = b.st[1];
        if (nloc == 0u) { xcd_barrier_complete(bar, b.x, nloc, nx); b.st[0] = nloc; b.st[1] = nx; }
        const unsigned old = xb_add(&bar[XB_XSUB(b.x)], 1u);
        const unsigned gen = old / nloc;
        if (old + 1u == (gen + 1u) * nloc) {
            __builtin_amdgcn_fence(__ATOMIC_RELEASE, "agent");
            asm volatile("s_waitcnt vmcnt(0)" ::: "memory");
            const unsigned og = xb_add(&bar[XB_TOP], 1u);
            const unsigned tg = og / nx;
            if (og + 1u == (tg + 1u) * nx) xb_add(&bar[XB_TOPGEN], 1u);
            else XB_SPIN(xb_ld(&bar[XB_TOPGEN]) == tg, bar);
            __builtin_amdgcn_fence(__ATOMIC_ACQUIRE, "agent");
            xb_add(&bar[XB_XGEN(b.x)], 1u);
            asm volatile("s_waitcnt vmcnt(0)" ::: "memory");
        } else {
            XB_SPIN(xb_ld(&bar[XB_XGEN(b.x)]) == gen, bar);
            __builtin_amdgcn_fence(__ATOMIC_ACQUIRE, "agent");
            asm volatile("s_waitcnt vmcnt(0)" ::: "memory");
        }
    }
    __syncthreads();
}


__global__ void __launch_bounds__(512, 2) hyena_fwd(Params p) {
    extern __shared__ __attribute__((aligned(16))) unsigned char smem[];
    cg::grid_group grid = cg::this_grid();
    __shared__ uint4 xb_words;
    if (threadIdx.x == 0) xb_words = make_uint4(0u, 0u, 0u, 0u);
    __syncthreads();
    const bool coop = (p.phase_hi - p.phase_lo) > 1;
    XcdBarrier xb; xb.bar = (unsigned*)(p.ws + WS_BAR); xb.x = 0; xb.st = (volatile LAS unsigned*)&xb_words;
    if (coop) xb = xcd_barrier_post((unsigned*)(p.ws + WS_BAR), (volatile LAS unsigned*)&xb_words);
    if (p.phase_hi > 1000) grid.sync();
#ifndef REP_PH
#define REP_PH -1
#endif
#define PH_ON(i) (p.phase_lo <= (i) && (i) < p.phase_hi)
#define PH_REP(i) for (int rep_ = 0; rep_ < ((i) == REP_PH ? 2 : 1); ++rep_)
#define PH_SYNC(i) do { if (PH_ON(i) && (i) + 1 < p.phase_hi) xcd_barrier(xb); } while (0)
    if (PH_ON(0)) PH_REP(0) {
        const int nmem = (gridDim.x + 1) / 2, ncmp = gridDim.x - nmem;
        if (gridDim.x < 2) { ph_weights<2>(p, 0, 1); ph_rmsnorm_in(p.in[0], (bf16_t*)(p.ws + WS_XN), 0, 1); ph_filters(p, (float*)smem, 0, 1); }
        else if ((blockIdx.x & 1) == 0) { ph_weights<0>(p, blockIdx.x >> 1, nmem); ph_rmsnorm_in(p.in[0], (bf16_t*)(p.ws + WS_XN), blockIdx.x >> 1, nmem); }
        else { ph_filters(p, (float*)smem, blockIdx.x >> 1, ncmp); ph_weights<1>(p, blockIdx.x >> 1, ncmp); }
    }
    PH_SYNC(0);
    if (PH_ON(1)) PH_REP(1) {
        pg8::StaticOrder S;
        { pg8::Gemm g{(const bf16_t*)(p.ws + WS_W1T), (const bf16_t*)(p.ws + WS_XN), 2048, NTOK, 1024};
          pg8::EpiBf16<0> E{(bf16_t*)(p.ws + WS_PT), NTOK, nullptr, 0, 0};
          S.init(g.M, g.N, gridDim.x, blockIdx.x);
          pg8::gemm_phase<pg8::EpiBf16<0>, pg8::StaticOrder, false>((PG8_LAS unsigned char*)smem, g, S, E, nullptr); }
        __syncthreads();
        { pg8::Gemm g{(const bf16_t*)(p.ws + WS_XN), (const bf16_t*)(p.ws + WS_W1T) + (size_t)2048 * 1024, NTOK, 1024, 1024};
          pg8::EpiBf16<0> E{(bf16_t*)(p.ws + WS_PR), 1024, nullptr, 0, 0};
          S.init(g.M, g.N, gridDim.x, blockIdx.x);
          pg8::gemm_phase<pg8::EpiBf16<0>, pg8::StaticOrder, false>((PG8_LAS unsigned char*)smem, g, S, E, nullptr); }
    }
    PH_SYNC(1);
    if (PH_ON(2)) PH_REP(2) ph_fftconv(p, (float2*)smem);
    PH_SYNC(2);
    if (PH_ON(3)) PH_REP(3) ph_mix(p, smem);
    PH_SYNC(3);
    if (PH_ON(4)) PH_REP(4) {
        pg8::StaticOrder S;
        pg8::Gemm g{(const bf16_t*)(p.ws + WS_A2), (const bf16_t*)(p.ws + WS_W2T), NTOK, 1024, 1024};
        pg8::EpiBf16<0> E{(bf16_t*)(p.ws + WS_OUTB), 1024, nullptr, 0, 0};
        S.init(g.M, g.N, gridDim.x, blockIdx.x);
        pg8::gemm_phase<pg8::EpiBf16<0>, pg8::StaticOrder, false>((PG8_LAS unsigned char*)smem, g, S, E, nullptr);
    }
    PH_SYNC(4);
    if (PH_ON(5)) PH_REP(5) ph_final(p);
}

#ifndef COOP
#define COOP 1
#endif
extern "C" void kernel_launch(void* const* d_in, const int* in_sizes, int n_in, void* d_out, int out_size, void* d_ws, size_t ws_size, hipStream_t stream) {
    static int grid_blocks = 0;
    if (!grid_blocks) {
        int dev = 0, cus = 0, per_cu = 0;
        (void)hipGetDevice(&dev);
        (void)hipDeviceGetAttribute(&cus, hipDeviceAttributeMultiprocessorCount, dev);
        (void)hipFuncSetAttribute((const void*)hyena_fwd, hipFuncAttributeMaxDynamicSharedMemorySize, LDS_BYTES);
        (void)hipOccupancyMaxActiveBlocksPerMultiprocessor(&per_cu, (const void*)hyena_fwd, NTHREADS, LDS_BYTES);
        if (per_cu < 1) { fprintf(stderr, "occupancy query says %d blocks/CU\n", per_cu); per_cu = 1; }
        grid_blocks = cus * 1;
        (void)hipGetLastError();
    }
    Params p{};
    for (int i = 0; i < 20; ++i) p.in[i] = (const float*)d_in[i];
    p.out = (float*)d_out; p.ws = (unsigned char*)d_ws;
#if COOP
    (void)hipMemsetAsync((unsigned char*)d_ws + WS_BAR, 0, XCD_BAR_WORDS * sizeof(unsigned), stream);
    p.phase_lo = 0; p.phase_hi = NPHASE;
    void* args[] = {&p};
    hipError_t e = hipLaunchCooperativeKernel((const void*)hyena_fwd, dim3(grid_blocks), dim3(NTHREADS), args, LDS_BYTES, stream);
    if (e != hipSuccess) fprintf(stderr, "cooperative launch failed: %s (grid %d)\n", hipGetErrorString(e), grid_blocks);
#else
    for (int ph = 0; ph < NPHASE; ++ph) {
        p.phase_lo = ph; p.phase_hi = ph + 1;
        hipLaunchKernelGGL(hyena_fwd, dim3(grid_blocks), dim3(NTHREADS), LDS_BYTES, stream, p);
    }
#endif
}
```

```cpp
#include <hip/hip_runtime.h>
#include <hip/hip_cooperative_groups.h>
#include <cstdio>
namespace cg = cooperative_groups;
namespace pg8 {
#define PG8_LAS __attribute__((address_space(3)))
typedef unsigned short bf16_t;
typedef short bf16x8 __attribute__((ext_vector_type(8)));
typedef float f32x4 __attribute__((ext_vector_type(4)));
typedef unsigned u32x4 __attribute__((ext_vector_type(4)));
constexpr int BM = 256, BK = 64, HALF = 128, HTB = HALF * BK * 2  , STAGE_BYTES = 8 * HTB, NXCD = 8, WGM = 8;

__host__ __device__ __forceinline__ int lds_byte(int r, int c) { const int st = (r >> 4) * 2 + (c >> 5), rr = r & 15, cc = c & 31, ob = rr * 64 + cc * 2; return st * 1024 + (ob ^ (((ob >> 9) & 1) << 5)); }
__host__ __device__ __forceinline__ void stage_rc(int b, int& R, int& C) { const int st = b / 1024, sb = b % 1024, swz = sb ^ (((sb >> 9) & 1) << 5); R = (st >> 1) * 16 + swz / 64; C = (st & 1) * 32 + (swz % 64) / 2; }
__host__ __device__ __forceinline__ int perm32(int rho) { const int n = rho >> 4, i = rho & 15; return 8 * (i >> 2) + 4 * n + (i & 3); }
struct Unit { int pm, pn; };
struct Gemm { const bf16_t* A; const bf16_t* Bt; int M, N, K; };

struct StaticOrder {
    int nM, nN, nwg, G, c;
    __host__ __device__ void init(int M, int N, int G_, int c_) { nM = M / BM; nN = N / BM; nwg = nM * nN; G = G_; c = c_; }
    __host__ __device__ bool next(int i, Unit& u) const {
        const long L = (long)i * G + c; if (L >= nwg) return false;
        int wgid = (int)L; { const int q = nwg / NXCD, r = nwg % NXCD, xcd = wgid % NXCD, off = wgid / NXCD; wgid = (xcd < r ? xcd * (q + 1) : r * (q + 1) + (xcd - r) * q) + off; }
        const int nig = WGM * nN, gid = wgid / nig, fm = gid * WGM, gsz = (nM - fm) < WGM ? (nM - fm) : WGM;
        u.pm = fm + ((wgid % nig) % gsz); u.pn = (wgid % nig) / gsz; return true;
    }
    __device__ __forceinline__ void a_ready(const Unit&) const {}
    __device__ __forceinline__ void done(const Unit&) const {}
};
__device__ __forceinline__ unsigned cvt_pk_bf16(float lo, float hi) { unsigned r; asm volatile("v_cvt_pk_bf16_f32 %0, %1, %2" : "=v"(r) : "v"(lo), "v"(hi)); return r; }
typedef float f32x2 __attribute__((ext_vector_type(2)));
__device__ __forceinline__ f32x2 gelu_pk(f32x2 v) {
    const f32x2 av = __builtin_elementwise_abs(v), d = av * 0.2316418882f + 1.0f;
    f32x2 t; t.x = __builtin_amdgcn_rcpf(d.x); t.y = __builtin_amdgcn_rcpf(d.y);
    f32x2 q = t * 0.5307027145f + (-0.7265760135f); q = q * t + 0.7107068705f; q = q * t + (-0.142248368f); q = q * t + 0.127414796f; q = q * t;
    const f32x2 s = (v * v) * (-0.72134752044f);
    f32x2 e; e.x = __builtin_amdgcn_exp2f(s.x); e.y = __builtin_amdgcn_exp2f(s.y);
    const f32x2 m = v * (q * e), r = v - m;
    f32x2 o; o.x = v.x < 0.f ? m.x : r.x; o.y = v.y < 0.f ? m.y : r.y; return o;
}

struct EpiF32 {
    static constexpr bool PERM = false, AFTER_DRAIN = false;
    float* C; int ldc; const float* bias;
    __device__ __forceinline__ void operator()(const f32x4 (&acc)[2][2][4][2], const Unit& u, int wr, int wc, int fr, int fq) const {
        const int row0 = u.pm * BM + wr * 64 + fr, col0 = u.pn * BM + wc * 32 + 4 * fq;
        f32x4 bv[2][2];
#pragma unroll
        for (int bj = 0; bj < 2; ++bj)
#pragma unroll
            for (int n = 0; n < 2; ++n) bv[bj][n] = bias ? *(const f32x4*)(bias + col0 + bj * HALF + n * 16) : (f32x4){0.f, 0.f, 0.f, 0.f};
#pragma unroll
        for (int ai = 0; ai < 2; ++ai)
#pragma unroll
            for (int m = 0; m < 4; ++m) { float* rowp = C + (size_t)(row0 + ai * HALF + m * 16) * ldc + col0;
#pragma unroll
                for (int bj = 0; bj < 2; ++bj)
#pragma unroll
                    for (int n = 0; n < 2; ++n) *(f32x4*)(rowp + bj * HALF + n * 16) = acc[ai][bj][m][n] + bv[bj][n]; }
    }
};
template <int ACT  > struct EpiBf16 {
    static constexpr bool PERM = true, AFTER_DRAIN = false;
    bf16_t* O; int ldc; const float* bias; int split_cols; size_t split_stride;
    __device__ __forceinline__ void operator()(const f32x4 (&acc)[2][2][4][2], const Unit& u, int wr, int wc, int fr, int fq) const {
        const int row0 = u.pm * BM + wr * 64 + fr; int colt = u.pn * BM; bf16_t* base = O;
        if (split_cols) { const int t = colt / split_cols; base += (size_t)t * split_stride; colt -= t * split_cols; }
        const int col0 = colt + wc * 32 + 8 * fq, bcol0 = u.pn * BM + wc * 32 + 8 * fq;
        f32x4 bv[2][2];
#pragma unroll
        for (int bj = 0; bj < 2; ++bj)
#pragma unroll
            for (int n = 0; n < 2; ++n) bv[bj][n] = bias ? *(const f32x4*)(bias + bcol0 + bj * HALF + 4 * n) : (f32x4){0.f, 0.f, 0.f, 0.f};
#pragma unroll
        for (int ai = 0; ai < 2; ++ai)
#pragma unroll
            for (int m = 0; m < 4; ++m) { bf16_t* rowp = base + (size_t)(row0 + ai * HALF + m * 16) * ldc + col0;
#pragma unroll
                for (int bj = 0; bj < 2; ++bj) { f32x4 v0 = acc[ai][bj][m][0] + bv[bj][0], v1 = acc[ai][bj][m][1] + bv[bj][1];
                    if (ACT == 1) { f32x2 a = gelu_pk((f32x2){v0[0], v0[1]}), b = gelu_pk((f32x2){v0[2], v0[3]}), c = gelu_pk((f32x2){v1[0], v1[1]}), d = gelu_pk((f32x2){v1[2], v1[3]});
                        v0 = (f32x4){a.x, a.y, b.x, b.y}; v1 = (f32x4){c.x, c.y, d.x, d.y}; }
                    if (ACT == 2) {
#pragma unroll
                        for (int j = 0; j < 4; ++j) { v0[j] = 0.5f * v0[j] * (1.0f + erff(v0[j] * 0.70710678f)); v1[j] = 0.5f * v1[j] * (1.0f + erff(v1[j] * 0.70710678f)); } }
                    u32x4 w; w.x = cvt_pk_bf16(v0[0], v0[1]); w.y = cvt_pk_bf16(v0[2], v0[3]); w.z = cvt_pk_bf16(v1[0], v1[1]); w.w = cvt_pk_bf16(v1[2], v1[3]);
                    *(u32x4*)(rowp + bj * HALF) = w; } }
    }
};

template <class Epi, class Sched, bool STAMP = false>
__device__ __forceinline__ void gemm_phase(PG8_LAS unsigned char* lds, const Gemm g, const Sched& S, const Epi& E, unsigned long long* stamps) {
    const int tid = threadIdx.x, wid = __builtin_amdgcn_readfirstlane(tid >> 6), lane = tid & 63, wr = wid >> 2, wc = wid & 3, fr = lane & 15, fq = lane >> 4;
    const int K = g.K, nt = K / BK;
    int ts_lo = 0, ts_hi = 0, nts = 0; const unsigned long long rt_entry = STAMP ? (unsigned long long)wall_clock64() : 0ull;
#define PG8_STAMP() do { if (STAMP && wid == 0 && nts < 64) { const unsigned long long _c = (unsigned long long)clock64(); \
        ts_lo = (lane == nts) ? (int)(unsigned)_c : ts_lo; ts_hi = (lane == nts) ? (int)(unsigned)(_c >> 32) : ts_hi; ++nts; } } while (0)
    PG8_STAMP();
    unsigned voffA[2], voffB[2];
#pragma unroll
    for (int i = 0; i < 2; ++i) { int R, C; stage_rc(tid * 16 + i * 8192, R, C); const int Rb = Epi::PERM ? ((R & ~31) + perm32(R & 31)) : R;
        voffA[i] = (unsigned)(R * K + C) * 2u; voffB[i] = (unsigned)(Rb * K + C) * 2u; }
    const size_t kstep = (size_t)(BK * 2);
    const size_t hstep = (size_t)HALF * K * 2;
    const size_t tstep = 2 * hstep;
    const unsigned ldsw = (unsigned)wid * 1024u;
    const int aoff = lds_byte(wr * 64 + fr, fq * 8), boff = lds_byte(wc * 32 + fr, fq * 8);
#define PG8_SA(b, h) (((b) * 2 + (h)) * HTB)
#define PG8_SB(b, h) ((4 + (b) * 2 + (h)) * HTB)
#define PG8_STAGE(bufoff, gbase, voff) do { _Pragma("unroll") for (int _i = 0; _i < 2; ++_i) \
        __builtin_amdgcn_global_load_lds((const unsigned*)((const char*)(gbase) + (voff)[_i]), (PG8_LAS unsigned*)(lds + (bufoff) + ldsw + _i * 8192), 16, 0, 0); } while (0)
#define PG8_LDA(dst, b, h) do { _Pragma("unroll") for (int m = 0; m < 4; ++m) _Pragma("unroll") for (int k = 0; k < 2; ++k) dst[m][k] = *(const PG8_LAS bf16x8*)(lds + PG8_SA(b, h) + aoff + m * 2048 + k * 1024); } while (0)
#define PG8_LDB(dst, b, h) do { _Pragma("unroll") for (int n = 0; n < 2; ++n) _Pragma("unroll") for (int k = 0; k < 2; ++k) dst[n][k] = *(const PG8_LAS bf16x8*)(lds + PG8_SB(b, h) + boff + n * 2048 + k * 1024); } while (0)
#define PG8_MMA(ai, bj, At, Bt) do { __builtin_amdgcn_s_setprio(1); _Pragma("unroll") for (int m = 0; m < 4; ++m) _Pragma("unroll") for (int n = 0; n < 2; ++n) _Pragma("unroll") for (int k = 0; k < 2; ++k) \
        acc[ai][bj][m][n] = __builtin_amdgcn_mfma_f32_16x16x32_bf16(Bt[n][k], At[m][k], acc[ai][bj][m][n], 0, 0, 0); __builtin_amdgcn_s_setprio(0); } while (0)
#define PG8_WAIT_V(n) asm volatile("s_waitcnt vmcnt(" #n ")" ::: "memory")
#define PG8_WAIT_L(n) asm volatile("s_waitcnt lgkmcnt(" #n ")" ::: "memory")
#define PG8_BAR __builtin_amdgcn_s_barrier()
#define PG8_SCHED __builtin_amdgcn_sched_barrier(0)
    Unit cur, nxt; int ui = 0;
    if (!S.next(0, cur)) return;
    f32x4 acc[2][2][4][2];
#pragma unroll
    for (int a = 0; a < 2; ++a)
#pragma unroll
        for (int b = 0; b < 2; ++b)
#pragma unroll
            for (int m = 0; m < 4; ++m)
#pragma unroll
                for (int n = 0; n < 2; ++n) acc[a][b][m][n] = (f32x4){0.f, 0.f, 0.f, 0.f};
    bf16x8 At[4][2], B0[2][2], B1[2][2];
    const char* cA = (const char*)g.A + (size_t)cur.pm * tstep; const char* cB = (const char*)g.Bt + (size_t)cur.pn * tstep;
    S.a_ready(cur);
    PG8_STAGE(PG8_SB(0, 0), cB, voffB); PG8_STAGE(PG8_SA(0, 0), cA, voffA); PG8_STAGE(PG8_SB(0, 1), cB + hstep, voffB); PG8_STAGE(PG8_SA(0, 1), cA + hstep, voffA);
    if (wr == 1) PG8_BAR;
    PG8_WAIT_V(4); PG8_BAR;
    PG8_STAGE(PG8_SB(1, 0), cB + kstep, voffB); PG8_STAGE(PG8_SA(1, 0), cA + kstep, voffA); PG8_STAGE(PG8_SB(1, 1), cB + hstep + kstep, voffB);
    PG8_WAIT_V(6); PG8_BAR;
    PG8_STAMP();
    for (;;) {
        const bool has_next = S.next(ui + 1, nxt);
        const char* nA = has_next ? (const char*)g.A + (size_t)nxt.pm * tstep : cA; const char* nB = has_next ? (const char*)g.Bt + (size_t)nxt.pn * tstep : cB;
        for (int t = 0; t < nt; t += 2) {
            const bool last = (t == nt - 2);
            const char* a1 = cA + (size_t)(t + 1) * kstep;
            const char* a2 = last ? nA : cA + (size_t)(t + 2) * kstep; const char* b2 = last ? nB : cB + (size_t)(t + 2) * kstep;
            const char* a3 = a2 + kstep; const char* b3 = b2 + kstep;
            if (last && has_next) S.a_ready(nxt);
            PG8_LDB(B0, 0, 0); PG8_SCHED; PG8_LDA(At, 0, 0); PG8_STAGE(PG8_SA(1, 1), a1 + hstep, voffA);
            PG8_WAIT_L(8); PG8_BAR; PG8_WAIT_L(0); PG8_MMA(0, 0, At, B0); PG8_BAR; PG8_SCHED;
            PG8_LDB(B1, 0, 1); PG8_STAGE(PG8_SB(0, 0), b2, voffB);
            PG8_BAR; PG8_WAIT_L(0); PG8_MMA(0, 1, At, B1); PG8_BAR;
            PG8_LDA(At, 0, 1); PG8_STAGE(PG8_SA(0, 0), a2, voffA);
            PG8_BAR; PG8_WAIT_L(0); PG8_MMA(1, 0, At, B0); PG8_BAR; PG8_SCHED;
            PG8_STAGE(PG8_SB(0, 1), b2 + hstep, voffB);
            PG8_WAIT_V(6); PG8_BAR; PG8_MMA(1, 1, At, B1); PG8_BAR;
            PG8_LDB(B0, 1, 0); PG8_SCHED; PG8_LDA(At, 1, 0); PG8_STAGE(PG8_SA(0, 1), a2 + hstep, voffA);
            PG8_WAIT_L(8); PG8_BAR; PG8_WAIT_L(0); PG8_MMA(0, 0, At, B0); PG8_BAR; PG8_SCHED;
            PG8_LDB(B1, 1, 1); PG8_STAGE(PG8_SB(1, 0), b3, voffB);
            PG8_BAR; PG8_WAIT_L(0); PG8_MMA(0, 1, At, B1); PG8_BAR;
            PG8_LDA(At, 1, 1); PG8_STAGE(PG8_SA(1, 0), a3, voffA);
            PG8_BAR; PG8_WAIT_L(0); PG8_MMA(1, 0, At, B0); PG8_BAR; PG8_SCHED;
            PG8_STAGE(PG8_SB(1, 1), b3 + hstep, voffB);
            PG8_WAIT_V(6); PG8_BAR; PG8_MMA(1, 1, At, B1); PG8_BAR;
        }
        PG8_STAMP();
        if constexpr (!Epi::AFTER_DRAIN) { E(acc, cur, wr, wc, fr, fq); S.done(cur); }
        PG8_STAMP();
        if (!has_next) break;
#pragma unroll
        for (int a = 0; a < 2; ++a)
#pragma unroll
            for (int b = 0; b < 2; ++b)
#pragma unroll
                for (int m = 0; m < 4; ++m)
#pragma unroll
                    for (int n = 0; n < 2; ++n) acc[a][b][m][n] = (f32x4){0.f, 0.f, 0.f, 0.f};
        cur = nxt; cA = nA; cB = nB; ++ui;
    }
    PG8_WAIT_V(0);
    if (wr == 0) PG8_BAR;
    PG8_BAR;
    if constexpr (Epi::AFTER_DRAIN) { E.fused(acc, cur, wr, wc, fr, fq, lds, wid, lane); S.done(cur); }
    PG8_STAMP();
    if (STAMP && wid == 0) { stamps[lane] = lane < nts ? (((unsigned long long)(unsigned)ts_hi << 32) | (unsigned)ts_lo) : 0ull;
        if (lane == 62) stamps[62] = rt_entry; if (lane == 63) stamps[63] = (unsigned long long)wall_clock64(); }
#undef PG8_STAMP
#undef PG8_SA
#undef PG8_SB
#undef PG8_STAGE
#undef PG8_LDA
#undef PG8_LDB
#undef PG8_MMA
#undef PG8_WAIT_V
#undef PG8_WAIT_L
#undef PG8_BAR
#undef PG8_SCHED
}
}
using pg8::bf16_t; using pg8::bf16x8; using pg8::f32x4; using pg8::u32x4; using pg8::cvt_pk_bf16;

constexpr int DM = 1024, NBATCH = 4, SEQ = 8192, NTOK = NBATCH * SEQ, HWD = 512, FN = 16384;
constexpr int NTHREADS = 512;
constexpr size_t MBY = 1024 * 1024;
constexpr size_t WS_XN = 0, WS_PT = 64 * MBY, WS_PR = 192 * MBY, WS_KF = 256 * MBY, WS_GT = 320 * MBY, WS_W1T = 352 * MBY, WS_W2T = 358 * MBY, WS_PWT = 360 * MBY, WS_KS = 361 * MBY, WS_BAR = 430 * MBY;
constexpr size_t WS_A2 = WS_XN, WS_OUTB = WS_PT;
constexpr int LDS_BYTES = 154624;
constexpr int NPHASE = 6;

struct Params {
    const float* in[20];
    float* out;
    unsigned char* ws;
    int phase_lo, phase_hi;
};

__device__ __forceinline__ float bf2f(bf16_t v) { return __uint_as_float((unsigned)v << 16); }
__device__ __forceinline__ bf16_t f2bf(float v) { return (bf16_t)(cvt_pk_bf16(v, 0.f) & 0xffffu); }
__device__ __forceinline__ float wave_sum(float v) {
#pragma unroll
    for (int o = 32; o; o >>= 1) v += __shfl_xor(v, o);
    return v;
}
__device__ __forceinline__ float silu(float z) { return z * __builtin_amdgcn_rcpf(1.0f + __expf(-z)); }

__device__ __forceinline__ void ph_rmsnorm_in(const float* __restrict__ x, bf16_t* __restrict__ xn, int vb, int nvb) {
    const int lane = threadIdx.x & 63, wid = threadIdx.x >> 6;
    for (int row0 = (vb * 8 + wid) * 2; row0 < NTOK; row0 += nvb * 16) {
        float4 a[2][4];
#pragma unroll
        for (int rr = 0; rr < 2; ++rr) {
            const float4* xr = (const float4*)(x + (size_t)(row0 + rr) * DM);
            a[rr][0] = xr[lane * 2]; a[rr][1] = xr[lane * 2 + 1]; a[rr][2] = xr[128 + lane * 2]; a[rr][3] = xr[129 + lane * 2];
        }
#pragma unroll
        for (int rr = 0; rr < 2; ++rr) {
            float ss = 0.f;
#pragma unroll
            for (int i = 0; i < 4; ++i) ss += a[rr][i].x * a[rr][i].x + a[rr][i].y * a[rr][i].y + a[rr][i].z * a[rr][i].z + a[rr][i].w * a[rr][i].w;
            ss = wave_sum(ss);
            const float r = rsqrtf(ss * (1.0f / DM) + 1e-6f);
            u32x4 w0, w1;
            w0.x = cvt_pk_bf16(a[rr][0].x * r, a[rr][0].y * r); w0.y = cvt_pk_bf16(a[rr][0].z * r, a[rr][0].w * r); w0.z = cvt_pk_bf16(a[rr][1].x * r, a[rr][1].y * r); w0.w = cvt_pk_bf16(a[rr][1].z * r, a[rr][1].w * r);
            w1.x = cvt_pk_bf16(a[rr][2].x * r, a[rr][2].y * r); w1.y = cvt_pk_bf16(a[rr][2].z * r, a[rr][2].w * r); w1.z = cvt_pk_bf16(a[rr][3].x * r, a[rr][3].y * r); w1.w = cvt_pk_bf16(a[rr][3].z * r, a[rr][3].w * r);
            *(u32x4*)(xn + (size_t)(row0 + rr) * DM + lane * 8) = w0;
            *(u32x4*)(xn + (size_t)(row0 + rr) * DM + 512 + lane * 8) = w1;
        }
    }
}

__device__ __forceinline__ void ph_weights(const Params& p, int vb, int nvb) {
    const int gt = vb * NTHREADS + threadIdx.x, gs = nvb * NTHREADS;
    const float* __restrict__ w_in = p.in[2]; const float* __restrict__ g = p.in[1];
    const float* __restrict__ w_out = p.in[18]; const float* __restrict__ pw = p.in[14];
    bf16_t* W1t = (bf16_t*)(p.ws + WS_W1T); bf16_t* W2t = (bf16_t*)(p.ws + WS_W2T); bf16_t* PWt = (bf16_t*)(p.ws + WS_PWT);
    for (int i = gt; i < 128 * 3072; i += gs) {
        const int n = i % 3072, k8 = i / 3072; float v[8];
#pragma unroll
        for (int e = 0; e < 8; ++e) v[e] = w_in[(size_t)(k8 * 8 + e) * 3072 + n] * g[k8 * 8 + e];
        u32x4 w; w.x = cvt_pk_bf16(v[0], v[1]); w.y = cvt_pk_bf16(v[2], v[3]); w.z = cvt_pk_bf16(v[4], v[5]); w.w = cvt_pk_bf16(v[6], v[7]);
        *(u32x4*)(W1t + (size_t)n * 1024 + k8 * 8) = w;
    }
    for (int i = gt; i < 128 * 1024; i += gs) {
        const int n = i & 1023, k8 = i >> 10; float v[8];
#pragma unroll
        for (int e = 0; e < 8; ++e) v[e] = w_out[(size_t)(k8 * 8 + e) * 1024 + n];
        u32x4 w; w.x = cvt_pk_bf16(v[0], v[1]); w.y = cvt_pk_bf16(v[2], v[3]); w.z = cvt_pk_bf16(v[4], v[5]); w.w = cvt_pk_bf16(v[6], v[7]);
        *(u32x4*)(W2t + (size_t)n * 1024 + k8 * 8) = w;
    }
    for (int i = gt; i < 4 * 16 * 128; i += gs) {
        const int d = i & 127, c8 = (i >> 7) & 15, gq = i >> 11; float v[8];
#pragma unroll
        for (int e = 0; e < 8; ++e) v[e] = pw[gq * 16384 + (c8 * 8 + e) * 128 + d];
        u32x4 w; w.x = cvt_pk_bf16(v[0], v[1]); w.y = cvt_pk_bf16(v[2], v[3]); w.z = cvt_pk_bf16(v[4], v[5]); w.w = cvt_pk_bf16(v[6], v[7]);
        *(u32x4*)(PWt + gq * 16384 + d * 128 + c8 * 8) = w;
    }
}

template <int KIN, int INSTRIDE> __device__ __forceinline__ void filt_layer(const float* __restrict__ hin, const float* __restrict__ wl, const float* __restrict__ bl, const float* __restrict__ fql, float* __restrict__ hout) {
    const int n = threadIdx.x & 63, pg = threadIdx.x >> 6;
    float acc[4];
#pragma unroll
    for (int i = 0; i < 4; ++i) acc[i] = bl[n];
#pragma unroll 8
    for (int f = 0; f < KIN; ++f) {
        const float w = wl[f * 64 + n];
#pragma unroll
        for (int i = 0; i < 4; ++i) acc[i] += hin[(pg * 4 + i) * INSTRIDE + f] * w;
    }
    const float fr = fql[n];
#pragma unroll
    for (int i = 0; i < 4; ++i) hout[(pg * 4 + i) * 64 + n] = __sinf(fr * acc[i]);
}
typedef _Float16 f16x8 __attribute__((ext_vector_type(8)));
typedef _Float16 f16x2 __attribute__((ext_vector_type(2)));
__device__ __forceinline__ unsigned pk_f16(float a, float b) { f16x2 h; h.x = (_Float16)a; h.y = (_Float16)b; return __builtin_bit_cast(unsigned, h); }
__device__ __forceinline__ void ph_filters(const Params& p, float* smf, int vb, int nvb) {
    float* wl1 = smf;
    float* wl2 = wl1 + 33 * 64;
    float* wl3 = wl2 + 64 * 64;
    float* bl = wl3 + 64 * 64;
    float* fql = bl + 192;
    float* zs = fql + 64;
    float* ha = zs + 32 * 36;
    float* hb = ha + 32 * 64;
    _Float16* h3h = (_Float16*)(hb + 32 * 64);
    _Float16* wT = h3h + 2 * 32 * 72;
    const float* __restrict__ w1 = p.in[5]; const float* __restrict__ b1 = p.in[6];
    const float* __restrict__ w2 = p.in[7]; const float* __restrict__ b2 = p.in[8];
    const float* __restrict__ w3 = p.in[9]; const float* __restrict__ b3 = p.in[10];
    const float* __restrict__ fq_ = p.in[11]; const float* __restrict__ wo = p.in[12];
    _Float16* __restrict__ kf = (_Float16*)(p.ws + WS_KF);
    const int tid = threadIdx.x, lane = tid & 63, wid = tid >> 6, fr = lane & 15, fq = lane >> 4;
    for (int i = tid; i < 33 * 64; i += NTHREADS) wl1[i] = w1[i];
    for (int i = tid; i < 64 * 64; i += NTHREADS) { wl2[i] = w2[i]; wl3[i] = w3[i]; }
    if (tid < 64) { bl[tid] = b1[tid]; bl[64 + tid] = b2[tid]; bl[128 + tid] = b3[tid]; fql[tid] = fq_[tid]; }
    for (int tbase = 2 * vb; tbase < SEQ / 32; tbase += 2 * nvb) {
        const int ntl = 2;
        for (int ti = 0; ti < ntl; ++ti) {
            const int l0 = (tbase + ti) * 32;
            __syncthreads();
            for (int i = tid; i < 32 * 33; i += NTHREADS) {
                const int pp = i / 33, f = i % 33, l = l0 + pp; float val;
                if (f == 0) val = (float)l * (1.0f / (float)(SEQ - 1));
                else {
                    const int bi = (f - 1) & 15;
                    const float band = 1e-4f + (float)bi * ((15.0f - 1e-4f) / 15.0f);
                    const float ang = 2.0f * 3.14159265358979323846f * (float)l / (float)SEQ;
                    const float a = band * ang;
                    val = (f <= 16) ? cosf(a) : -sinf(a);
                }
                zs[pp * 36 + f] = val;
            }
            __syncthreads();
            filt_layer<33, 36>(zs, wl1, bl, fql, ha);
            __syncthreads();
            filt_layer<64, 64>(ha, wl2, bl + 64, fql, hb);
            __syncthreads();
            filt_layer<64, 64>(hb, wl3, bl + 128, fql, ha);
            __syncthreads();
            for (int i = tid; i < 32 * 32; i += NTHREADS) { const int pp = i >> 5, k2 = (i & 31) * 2; *(unsigned*)(h3h + (ti * 32 + pp) * 72 + k2) = pk_f16(ha[pp * 64 + k2], ha[pp * 64 + k2 + 1]); }
        }
#pragma unroll 1
        for (int q = 0; q < 4; ++q) {
            __syncthreads();
            {
                const int c4 = tid & 127, k8 = tid >> 7;
#pragma unroll
                for (int hh = 0; hh < 2; ++hh) {
                    const int k0 = (k8 * 2 + hh) * 8;
                    f32x4 v[8];
#pragma unroll
                    for (int kk = 0; kk < 8; ++kk) v[kk] = *(const f32x4*)(wo + (size_t)(k0 + kk) * 2048 + q * 512 + c4 * 4);
#pragma unroll
                    for (int e = 0; e < 4; ++e) {
                        u32x4 w; w.x = pk_f16(v[0][e], v[1][e]); w.y = pk_f16(v[2][e], v[3][e]); w.z = pk_f16(v[4][e], v[5][e]); w.w = pk_f16(v[6][e], v[7][e]);
                        *(u32x4*)(wT + (c4 * 4 + e) * 72 + k0) = w;
                    }
                }
            }
            __syncthreads();
            const int o = q >> 1, dir = q & 1;
            f16x8 Bf[4][2];
#pragma unroll
            for (int n = 0; n < 4; ++n)
#pragma unroll
                for (int ks = 0; ks < 2; ++ks) Bf[n][ks] = *(const f16x8*)(wT + (wid * 64 + 16 * n + fr) * 72 + ks * 32 + fq * 8);
            for (int ti = 0; ti < ntl; ++ti) {
                const int l0 = (tbase + ti) * 32;
#pragma unroll
                for (int m = 0; m < 2; ++m) {
                    f16x8 Af[2];
#pragma unroll
                    for (int ks = 0; ks < 2; ++ks) Af[ks] = *(const f16x8*)(h3h + (ti * 32 + 16 * m + fr) * 72 + ks * 32 + fq * 8);
#pragma unroll
                    for (int n = 0; n < 4; ++n) {
                        f32x4 acc = (f32x4){0.f, 0.f, 0.f, 0.f};
                        acc = __builtin_amdgcn_mfma_f32_16x16x32_f16(Af[0], Bf[n][0], acc, 0, 0, 0);
                        acc = __builtin_amdgcn_mfma_f32_16x16x32_f16(Af[1], Bf[n][1], acc, 0, 0, 0);
                        const int c = wid * 64 + 16 * n + fr, lb = l0 + 16 * m + 4 * fq;
                        const float adel = 3.070113457325394f + (float)c * ((15.350567286626971f - 3.070113457325394f) / 511.0f);
                        float v[4];
#pragma unroll
                        for (int jj = 0; jj < 4; ++jj) v[jj] = acc[jj] * __expf(-(float)(lb + jj) * (1.0f / (float)(SEQ - 1)) * adel);
                        _Float16* dst = kf + ((size_t)(o * 2 + dir) * 512 + c) * SEQ + lb;
                        uint2 w; w.x = pk_f16(v[0], v[1]); w.y = pk_f16(v[2], v[3]);
                        *(uint2*)dst = w;
                    }
                }
            }
        }
    }
}

typedef float c2 __attribute__((ext_vector_type(2)));
__device__ __forceinline__ c2 mk2(float a, float b) { return (c2){a, b}; }
__device__ __forceinline__ c2 cmulf(c2 a, c2 b) { return a.x * b + a.y * (c2){-b.y, b.x}; }
__device__ __forceinline__ c2 cmulc(c2 a, c2 b) { return a.x * (c2){b.x, -b.y} + a.y * (c2){b.y, b.x}; }
__device__ __forceinline__ constexpr float tw_c(int k) { constexpr float t[16] = {1.000000000f, 0.980785280f, 0.923879533f, 0.831469612f, 0.707106781f, 0.555570233f, 0.382683432f, 0.195090322f, 0.000000000f, -0.195090322f, -0.382683432f, -0.555570233f, -0.707106781f, -0.831469612f, -0.923879533f, -0.980785280f}; return t[k]; }
__device__ __forceinline__ constexpr float tw_s(int k) { constexpr float t[16] = {0.000000000f, 0.195090322f, 0.382683432f, 0.555570233f, 0.707106781f, 0.831469612f, 0.923879533f, 0.980785280f, 1.000000000f, 0.980785280f, 0.923879533f, 0.831469612f, 0.707106781f, 0.555570233f, 0.382683432f, 0.195090322f}; return t[k]; }
__device__ __forceinline__ c2 swp(c2 a) { return __builtin_shufflevector(a, a, 1, 0); }
__device__ __forceinline__ c2 twf(c2 d, int k) {
    const float s = 0.70710678118f;
    if (k == 0) return d;
    if (k == 8) return swp(d) * (c2){1.f, -1.f};
    if (k == 4) return d * s + swp(d) * (c2){s, -s};
    if (k == 12) return d * (-s) + swp(d) * (c2){s, -s};
    return d * tw_c(k) + swp(d) * (c2){tw_s(k), -tw_s(k)};
}
__device__ __forceinline__ c2 twi(c2 d, int k) {
    const float s = 0.70710678118f;
    if (k == 0) return d;
    if (k == 8) return swp(d) * (c2){-1.f, 1.f};
    if (k == 4) return d * s + swp(d) * (c2){-s, s};
    if (k == 12) return d * (-s) + swp(d) * (c2){-s, s};
    return d * tw_c(k) + swp(d) * (c2){-tw_s(k), tw_s(k)};
}
__host__ __device__ constexpr int brev(int q, int bits) { int r = 0; for (int i = 0; i < bits; ++i) r |= ((q >> i) & 1) << (bits - 1 - i); return r; }

template <int R> __device__ __forceinline__ void twpow(c2 w1, c2 (&w)[R]) {
    w[0] = mk2(1.f, 0.f); w[1] = w1; w[2] = cmulf(w1, w1); w[3] = cmulf(w[2], w1); w[4] = cmulf(w[2], w[2]);
    w[8] = cmulf(w[4], w[4]); w[12] = cmulf(w[8], w[4]);
    if (R == 32) { w[16] = cmulf(w[8], w[8]); w[20] = cmulf(w[16], w[4]); w[24] = cmulf(w[16], w[8]); w[28] = cmulf(w[16], w[12]); }
#pragma unroll
    for (int j = 1; j < R / 4; ++j)
#pragma unroll
        for (int i = 1; i < 4; ++i) w[4 * j + i] = cmulf(w[4 * j], w[i]);
}
template <int R, bool ZPAD> __device__ __forceinline__ void dft_dif(c2 (&x)[R]) {
    constexpr int LG = (R == 32) ? 5 : 4;
#pragma unroll
    for (int st = 0; st < LG; ++st) {
        const int h = (R / 2) >> st;
#pragma unroll
        for (int t = 0; t < R / 2; ++t) {
            const int i = t & (h - 1), s = (t >> (LG - 1 - st)) * 2 * h, k = (i * 16) >> (LG - 1 - st);
            const c2 a = x[s + i];
            if (ZPAD && st == 0) { x[s + i + h] = twf(a, k); continue; }
            const c2 b = x[s + i + h];
            x[s + i] = a + b;
            x[s + i + h] = twf(a - b, k);
        }
    }
}
template <int R> __device__ __forceinline__ void dft_dit(c2 (&x)[R]) {
    constexpr int LG = (R == 32) ? 5 : 4;
#pragma unroll
    for (int st = 0; st < LG; ++st) {
        const int h = 1 << st;
#pragma unroll
        for (int t = 0; t < R / 2; ++t) {
            const int i = t & (h - 1), s = (t >> st) * 2 * h, k = (i * 16) >> st;
            const c2 a = x[s + i], b = twi(x[s + i + h], k);
            x[s + i] = a + b;
            x[s + i + h] = a - b;
        }
    }
}

template <bool FULL, class RAW, class LD, class FIN> __device__ __forceinline__ void fft_f1(c2* sm, const float4 wB, LD ld, FIN fin) {
#pragma unroll 1
    for (int jj = 0; jj < 2; ++jj) {
        int j = threadIdx.x + jj * 512; asm volatile("" : "+v"(j));
        RAW raw[FULL ? 16 : 8];
#pragma unroll
        for (int r = 0; r < (FULL ? 16 : 8); ++r) raw[r] = ld(j + r * 1024);
        c2 x[16];
#pragma unroll
        for (int r = 0; r < 16; ++r) { if (FULL || r < 8) { const float2 f = fin(raw[r < (FULL ? 16 : 8) ? r : 0], j + r * 1024); x[r] = mk2(f.x, f.y); } else x[r] = mk2(0.f, 0.f); }
        dft_dif<16, !FULL>(x);
        float wx = jj ? wB.z : wB.x, wy = jj ? wB.w : wB.y; asm volatile("" : "+v"(wx), "+v"(wy));
        c2 w[16]; twpow<16>(mk2(wx, wy), w);
        const int base = j + (j >> 5);
        sm[base] = x[0];
#pragma unroll
        for (int q = 1; q < 16; ++q) sm[base + q * 1056] = cmulf(x[brev(q, 4)], w[q]);
    }
}
typedef _Float16 h2_t __attribute__((ext_vector_type(2)));
__device__ __forceinline__ void fft_build_ctab(uint4* ctab) {
    for (int e = threadIdx.x; e < 1024; e += NTHREADS) {
        const int inv = e >> 9, mt = (e >> 7) & 3, s = (e >> 6) & 1, lane = e & 63, m = lane & 15, kq = lane >> 4, r = 16 * (mt & 1) + m;
        float v[8];
#pragma unroll
        for (int i = 0; i < 8; ++i) {
            const int k = inv ? (16 * (i >> 2) + 4 * kq + (i & 3)) : (8 * kq + i);
            float sn, cs; sincospif((float)((r * k) & 31) * (1.0f / 16.0f), &sn, &cs);
            if (!inv) v[i] = 0.25f * ((mt < 2) ? (s == 0 ? cs : sn) : (s == 0 ? -sn : cs));
            else      v[i] = 0.0625f * ((mt < 2) ? (s == 0 ? cs : -sn) : (s == 0 ? sn : cs));
        }
        uint4 w; w.x = pk_f16(v[0], v[1]); w.y = pk_f16(v[2], v[3]); w.z = pk_f16(v[4], v[5]); w.w = pk_f16(v[6], v[7]);
        ctab[e] = w;
    }
}
__device__ __forceinline__ f16x8 cvt8(float a0, float a1, float a2, float a3, float a4, float a5, float a6, float a7) {
    u32x4 w; w.x = pk_f16(a0, a1); w.y = pk_f16(a2, a3); w.z = pk_f16(a4, a5); w.w = pk_f16(a6, a7); return __builtin_bit_cast(f16x8, w);
}
template <bool FILTER> __device__ __forceinline__ void fft_f3_mfma(c2* sm, unsigned* __restrict__ K) {
    const int lane = threadIdx.x & 63, n = lane & 15, kq = lane >> 4;
    const uint4* ctab = (const uint4*)(sm + FN + 512);
    unsigned koff = threadIdx.x; asm volatile("" : "+v"(koff));
    unsigned kr[32];
    if (!FILTER) {
#pragma unroll
        for (int q = 0; q < 8; ++q) { const u32x4 k4 = *(const u32x4*)(K + (size_t)(q * 512 + koff) * 4); kr[4 * q] = k4[0]; kr[4 * q + 1] = k4[1]; kr[4 * q + 2] = k4[2]; kr[4 * q + 3] = k4[3]; }
    }
    f16x8 Af[4][2], Ai[4][2];
#pragma unroll
    for (int mt = 0; mt < 4; ++mt)
#pragma unroll
        for (int s = 0; s < 2; ++s) {
            Af[mt][s] = __builtin_bit_cast(f16x8, ctab[(mt * 2 + s) * 64 + lane]);
            if (!FILTER) Ai[mt][s] = __builtin_bit_cast(f16x8, ctab[512 + (mt * 2 + s) * 64 + lane]);
        }
#pragma unroll
    for (int g = 0; g < 4; ++g) {
        const int base = ((threadIdx.x & ~63) + g * 16 + n) * 33;
        c2 e[8];
#pragma unroll
        for (int i = 0; i < 8; ++i) e[i] = sm[base + 8 * kq + i];
        const f16x8 Bre = cvt8(e[0].x, e[1].x, e[2].x, e[3].x, e[4].x, e[5].x, e[6].x, e[7].x);
        const f16x8 Bim = cvt8(e[0].y, e[1].y, e[2].y, e[3].y, e[4].y, e[5].y, e[6].y, e[7].y);
        f32x4 D[4];
        __builtin_amdgcn_s_setprio(1);
#pragma unroll
        for (int mt = 0; mt < 4; ++mt) {
            D[mt] = __builtin_amdgcn_mfma_f32_16x16x32_f16(Af[mt][0], Bre, (f32x4){0.f, 0.f, 0.f, 0.f}, 0, 0, 0);
            D[mt] = __builtin_amdgcn_mfma_f32_16x16x32_f16(Af[mt][1], Bim, D[mt], 0, 0, 0);
        }
        __builtin_amdgcn_s_setprio(0);
        if (FILTER) {
#pragma unroll
            for (int t = 0; t < 2; ++t)
#pragma unroll
                for (int jj = 0; jj < 4; ++jj) K[(size_t)((g * 2 + t) * 512 + koff) * 4 + jj] = pk_f16(D[t][jj] * (1.0f / 2048.0f), D[t + 2][jj] * (1.0f / 2048.0f));
        } else {
            float yr[8], yi[8];
#pragma unroll
            for (int t = 0; t < 2; ++t)
#pragma unroll
                for (int jj = 0; jj < 4; ++jj) {
                    const h2_t h = __builtin_bit_cast(h2_t, kr[g * 8 + t * 4 + jj]);
                    const c2 y = cmulf(mk2(D[t][jj], D[t + 2][jj]), mk2((float)h.x, (float)h.y));
                    yr[t * 4 + jj] = y.x; yi[t * 4 + jj] = y.y;
                }
            const f16x8 Cre = cvt8(yr[0], yr[1], yr[2], yr[3], yr[4], yr[5], yr[6], yr[7]);
            const f16x8 Cim = cvt8(yi[0], yi[1], yi[2], yi[3], yi[4], yi[5], yi[6], yi[7]);
            f32x4 E[4];
#pragma unroll
            for (int mt = 0; mt < 4; ++mt) {
                E[mt] = __builtin_amdgcn_mfma_f32_16x16x32_f16(Ai[mt][0], Cre, (f32x4){0.f, 0.f, 0.f, 0.f}, 0, 0, 0);
                E[mt] = __builtin_amdgcn_mfma_f32_16x16x32_f16(Ai[mt][1], Cim, E[mt], 0, 0, 0);
            }
#pragma unroll
            for (int t = 0; t < 2; ++t)
#pragma unroll
                for (int jj = 0; jj < 4; ++jj) sm[base + 16 * t + 4 * kq + jj] = mk2(E[t][jj], E[t + 2][jj]);
        }
    }
}
__device__ __forceinline__ void fft_f3_mfma_pack(c2* sm, unsigned* __restrict__ K0, unsigned* __restrict__ K1) {
    const int lane = threadIdx.x & 63, n = lane & 15, kq = lane >> 4;
    const uint4* ctab = (const uint4*)(sm + FN + 512);
    f16x8 Af[4][2];
#pragma unroll
    for (int mt = 0; mt < 4; ++mt)
#pragma unroll
        for (int s = 0; s < 2; ++s) Af[mt][s] = __builtin_bit_cast(f16x8, ctab[(mt * 2 + s) * 64 + lane]);
#pragma unroll
    for (int g = 0; g < 4; ++g) {
        const int base = ((threadIdx.x & ~63) + g * 16 + n) * 33;
        c2 e[8];
#pragma unroll
        for (int i = 0; i < 8; ++i) e[i] = sm[base + 8 * kq + i];
        const f16x8 Bre = cvt8(e[0].x, e[1].x, e[2].x, e[3].x, e[4].x, e[5].x, e[6].x, e[7].x);
        const f16x8 Bim = cvt8(e[0].y, e[1].y, e[2].y, e[3].y, e[4].y, e[5].y, e[6].y, e[7].y);
        f32x4 D[4];
        __builtin_amdgcn_s_setprio(1);
#pragma unroll
        for (int mt = 0; mt < 4; ++mt) {
            D[mt] = __builtin_amdgcn_mfma_f32_16x16x32_f16(Af[mt][0], Bre, (f32x4){0.f, 0.f, 0.f, 0.f}, 0, 0, 0);
            D[mt] = __builtin_amdgcn_mfma_f32_16x16x32_f16(Af[mt][1], Bim, D[mt], 0, 0, 0);
        }
        __builtin_amdgcn_s_setprio(0);
#pragma unroll
        for (int t = 0; t < 2; ++t)
#pragma unroll
            for (int jj = 0; jj < 4; ++jj) sm[base + 16 * t + 4 * kq + jj] = mk2(D[t][jj], D[t + 2][jj]);
    }
    __syncthreads();
    unsigned koff = threadIdx.x; asm volatile("" : "+v"(koff));
#pragma unroll 1
    for (int g = 0; g < 4; ++g) {
        const int rho = (threadIdx.x & ~63) + g * 16 + n;
#pragma unroll
        for (int t = 0; t < 2; ++t) {
            unsigned o0[4], o1[4];
#pragma unroll
            for (int jj = 0; jj < 4; ++jj) {
                const int m = 16 * t + 4 * kq + jj;
                const int f = (rho >> 5) + 16 * (rho & 31) + 512 * m, fp = (FN - f) & (FN - 1);
                const int rp = 32 * (fp & 15) + ((fp >> 4) & 31), mp = fp >> 9;
                const c2 zf = sm[rho * 33 + m], zp = sm[rp * 33 + mp];
                const float s = 0.5f * 16.0f / 2048.0f;
                o0[jj] = pk_f16((zf.x + zp.x) * s, (zf.y - zp.y) * s);
                o1[jj] = pk_f16((zf.y + zp.y) * s, (zp.x - zf.x) * s);
            }
            *(u32x4*)(K0 + (size_t)((g * 2 + t) * 512 + koff) * 4) = (u32x4){o0[0], o0[1], o0[2], o0[3]};
            *(u32x4*)(K1 + (size_t)((g * 2 + t) * 512 + koff) * 4) = (u32x4){o1[0], o1[1], o1[2], o1[3]};
        }
    }
}
__device__ __forceinline__ void fft_twinv_build(float* tvl) {
    if (threadIdx.x < 64) {
        const int lane = threadIdx.x, n = lane & 15, kq = lane >> 4;
#pragma unroll
        for (int p = 0; p < 2; ++p) {
            const int j = 16 * p + n; float sn, cs;
            sincospif((float)(j & 1023) * (1.0f / 512.0f), &sn, &cs); tvl[(0 + p) * 64 + lane] = cs; tvl[(2 + p) * 64 + lane] = -sn;
            sincospif((float)((4 * kq * j) & 1023) * (1.0f / 512.0f), &sn, &cs); tvl[(4 + p) * 64 + lane] = cs; tvl[(6 + p) * 64 + lane] = -sn;
            sincospif((float)((16 * j) & 1023) * (1.0f / 512.0f), &sn, &cs); tvl[(8 + p) * 64 + lane] = cs; tvl[(10 + p) * 64 + lane] = -sn;
        }
    }
}
template <bool INV> __device__ __forceinline__ void fft_p2_mfma(c2* sm, const float* tv) {
    const int lane = threadIdx.x & 63, n = lane & 15, kq = lane >> 4;
    const uint4* ctab = (const uint4*)(sm + FN + 512);
    f16x8 Am[4][2];
#pragma unroll
    for (int mt = 0; mt < 4; ++mt)
#pragma unroll
        for (int s = 0; s < 2; ++s) Am[mt][s] = __builtin_bit_cast(f16x8, ctab[(INV ? 512 : 0) + (mt * 2 + s) * 64 + lane]);
#pragma unroll
    for (int g = 0; g < 4; ++g) {
        const int bf = (threadIdx.x & ~63) + g * 16 + n, base = (bf >> 5) * 1056 + (bf & 31);
        const int p_ = g & 1;
        const float ax = tv[(0 + p_) * 64 + lane], ay = tv[(2 + p_) * 64 + lane], bx = tv[(4 + p_) * 64 + lane], by = tv[(6 + p_) * 64 + lane], cx = tv[(8 + p_) * 64 + lane], cy = tv[(10 + p_) * 64 + lane];
        const c2 w1 = mk2(ax, ay), wk = mk2(bx, by), w16 = mk2(cx, cy);
        c2 tw[8];
        { const c2 w2 = cmulf(w1, w1), w3 = cmulf(w2, w1);
          tw[0] = wk; tw[1] = cmulf(wk, w1); tw[2] = cmulf(wk, w2); tw[3] = cmulf(wk, w3);
#pragma unroll
          for (int jj = 0; jj < 4; ++jj) tw[4 + jj] = cmulf(tw[jj], w16); }
        c2 e[8];
        if (!INV) {
#pragma unroll
            for (int i = 0; i < 8; ++i) e[i] = sm[base + (8 * kq + i) * 33];
        } else {
#pragma unroll
            for (int i = 0; i < 8; ++i) e[i] = cmulc(sm[base + (16 * (i >> 2) + 4 * kq + (i & 3)) * 33], tw[i]);
        }
        const f16x8 Bre = cvt8(e[0].x, e[1].x, e[2].x, e[3].x, e[4].x, e[5].x, e[6].x, e[7].x);
        const f16x8 Bim = cvt8(e[0].y, e[1].y, e[2].y, e[3].y, e[4].y, e[5].y, e[6].y, e[7].y);
        f32x4 D[4];
        __builtin_amdgcn_s_setprio(1);
#pragma unroll
        for (int mt = 0; mt < 4; ++mt) {
            D[mt] = __builtin_amdgcn_mfma_f32_16x16x32_f16(Am[mt][0], Bre, (f32x4){0.f, 0.f, 0.f, 0.f}, 0, 0, 0);
            D[mt] = __builtin_amdgcn_mfma_f32_16x16x32_f16(Am[mt][1], Bim, D[mt], 0, 0, 0);
        }
        __builtin_amdgcn_s_setprio(0);
#pragma unroll
        for (int t = 0; t < 2; ++t)
#pragma unroll
            for (int jj = 0; jj < 4; ++jj) {
                const c2 v = mk2(D[t][jj], D[t + 2][jj]);
                sm[base + (16 * t + 4 * kq + jj) * 33] = INV ? v : cmulf(v, tw[t * 4 + jj]);
            }
    }
}
__device__ __forceinline__ uint2 ldwin(const bf16_t* __restrict__ row, int l) { return *(const uint2*)(row + (int)((unsigned)(l - 1) & ~1u)); }
__device__ __forceinline__ float sconv_w(uint2 wv, int l, float w0, float w1, float w2, float b) {
    float a, m, n;
    if (l & 1) { a = __uint_as_float(wv.x << 16); m = __uint_as_float(wv.x & 0xffff0000u); n = __uint_as_float(wv.y << 16); }
    else       { a = __uint_as_float(wv.x & 0xffff0000u); m = __uint_as_float(wv.y << 16); n = __uint_as_float(wv.y & 0xffff0000u); }
    a = l > 0 ? a : 0.f; n = l < SEQ - 1 ? n : 0.f;
    return a * w0 + m * w1 + n * w2 + b;
}
template <bool FUSE_F1, class RAW, class GL, class GF, class EP> __device__ __forceinline__ void fft_i1(c2* sm, const float4 wB, GL gl, GF gf, EP ep) {
#pragma unroll 1
    for (int jj = 0; jj < 2; ++jj) {
        int j = threadIdx.x + jj * 512; asm volatile("" : "+v"(j));
        RAW raw[8];
#pragma unroll
        for (int r = 0; r < 8; ++r) raw[r] = gl(j + r * 1024);
        float wx = jj ? wB.z : wB.x, wy = jj ? wB.w : wB.y; asm volatile("" : "+v"(wx), "+v"(wy));
        c2 w[16]; twpow<16>(mk2(wx, wy), w);
        const int base = j + (j >> 5);
        c2 x[16];
        x[0] = sm[base];
#pragma unroll
        for (int q = 1; q < 16; ++q) x[brev(q, 4)] = cmulc(sm[base + q * 1056], w[q]);
        dft_dit<16>(x);
#pragma unroll
        for (int r = 0; r < 8; ++r) { const float2 g = gf(raw[r], j + r * 1024); x[r] = x[r] * mk2(g.x, g.y); }
        if (FUSE_F1) {
#pragma unroll
            for (int r = 8; r < 16; ++r) x[r] = mk2(0.f, 0.f);
            dft_dif<16, true>(x);
            sm[base] = x[0];
#pragma unroll
            for (int q = 1; q < 16; ++q) sm[base + q * 1056] = cmulf(x[brev(q, 4)], w[q]);
        } else {
#pragma unroll
            for (int r = 0; r < 8; ++r) ep(j + r * 1024, make_float2(x[r].x, x[r].y));
        }
    }
}

struct G2Raw { uint2 p0, p1; bf16_t z0, z1; };
#define SYNC_SB() do { __syncthreads(); __builtin_amdgcn_sched_barrier(0); } while (0)
#define WAVE_SB() do { __builtin_amdgcn_fence(__ATOMIC_RELEASE, "wavefront"); __builtin_amdgcn_wave_barrier(); __builtin_amdgcn_fence(__ATOMIC_ACQUIRE, "wavefront"); __builtin_amdgcn_sched_barrier(0); } while (0)
__device__ __forceinline__ void ph_fftconv(const Params& p, float2* sm_) {
    c2* sm = reinterpret_cast<c2*>(sm_);
    const bf16_t* pT = (const bf16_t*)(p.ws + WS_PT);
    const _Float16* kf = (const _Float16*)(p.ws + WS_KF);
    bf16_t* gT = (bf16_t*)(p.ws + WS_GT);
    unsigned* K0 = (unsigned*)(p.ws + WS_KS) + (size_t)blockIdx.x * 2 * FN; unsigned* K1 = K0 + FN;
    const float* conv_w = p.in[3]; const float* conv_b = p.in[4]; const float* hd = p.in[13];
    float4 wB;
    { float sn, cs;
      sincospif((float)threadIdx.x * (1.0f / 8192.0f), &sn, &cs); wB.x = cs; wB.y = -sn;
      sincospif((float)(threadIdx.x + 512) * (1.0f / 8192.0f), &sn, &cs); wB.z = cs; wB.w = -sn; }
    const float kscale = 16.0f * 256.0f * 2048.0f / (float)FN;
    fft_build_ctab((uint4*)(sm + FN + 512));
    float* tv = (float*)((unsigned char*)sm_ + 151552);
    fft_twinv_build(tv);
    __syncthreads();
    for (int c = blockIdx.x; c < HWD; c += gridDim.x) {
        {
            const _Float16* kf0 = kf + ((size_t)0 * 512 + c) * SEQ; const _Float16* kb0 = kf + ((size_t)1 * 512 + c) * SEQ;
            const _Float16* kf1 = kf + ((size_t)2 * 512 + c) * SEQ; const _Float16* kb1 = kf + ((size_t)3 * 512 + c) * SEQ;
            const float d0 = hd[c], d1 = hd[512 + c];
            fft_f1<true, h2_t>(sm, wB, [&](int i) -> h2_t { const int ib = (i == SEQ) ? 1 : 2 * SEQ - i; h2_t v; v.x = i < SEQ ? kf0[i] : kb0[ib]; v.y = i < SEQ ? kf1[i] : kb1[ib]; return v; },
                [&](h2_t v, int i) -> float2 { return i == SEQ ? make_float2(0.f, 0.f) : make_float2((float)v.x + (i == 0 ? d0 : 0.f), (float)v.y + (i == 0 ? d1 : 0.f)); });
            SYNC_SB(); fft_p2_mfma<false>(sm, tv); WAVE_SB(); fft_f3_mfma_pack(sm, K0, K1); SYNC_SB();
        }
        const bf16_t* r0 = pT + (size_t)c * NTOK; const bf16_t* r1 = pT + (size_t)(512 + c) * NTOK; const bf16_t* r2 = pT + (size_t)(1024 + c) * NTOK; const bf16_t* r3 = pT + (size_t)(1536 + c) * NTOK;
        const float a0 = conv_w[c], a1 = conv_w[1536 + c], a2 = conv_w[3072 + c], ab = conv_b[c];
        const float b0 = conv_w[512 + c] * kscale, b1 = conv_w[1536 + 512 + c] * kscale, b2 = conv_w[3072 + 512 + c] * kscale, bb = conv_b[512 + c] * kscale;
        const float c0 = conv_w[1024 + c] * kscale, c1 = conv_w[1536 + 1024 + c] * kscale, c2 = conv_w[3072 + 1024 + c] * kscale, cb = conv_b[1024 + c] * kscale;
        bf16_t* grow = gT + (size_t)c * NTOK;
#pragma unroll 1
        for (int pair = 0; pair < 2; ++pair) {
            const int t0 = pair * 2 * SEQ;
            fft_f1<false, uint4>(sm, wB, [&](int l) -> uint4 { const uint2 p0 = ldwin(r0 + t0, l), p1 = ldwin(r0 + t0 + SEQ, l); return make_uint4(p0.x, p0.y, p1.x, p1.y); },
                [&](uint4 v, int l) -> float2 { return make_float2(sconv_w(make_uint2(v.x, v.y), l, a0, a1, a2, ab), sconv_w(make_uint2(v.z, v.w), l, a0, a1, a2, ab)); });
            SYNC_SB(); fft_p2_mfma<false>(sm, tv); WAVE_SB(); fft_f3_mfma<false>(sm, K0); WAVE_SB(); fft_p2_mfma<true>(sm, tv); SYNC_SB();
            fft_i1<true, uint4>(sm, wB, [&](int l) -> uint4 { const uint2 p0 = ldwin(r1 + t0, l), p1 = ldwin(r1 + t0 + SEQ, l); return make_uint4(p0.x, p0.y, p1.x, p1.y); },
                [&](uint4 v, int l) -> float2 { return make_float2(sconv_w(make_uint2(v.x, v.y), l, b0, b1, b2, bb), sconv_w(make_uint2(v.z, v.w), l, b0, b1, b2, bb)); }, [&](int, float2) {});
            SYNC_SB(); fft_p2_mfma<false>(sm, tv); WAVE_SB(); fft_f3_mfma<false>(sm, K1); WAVE_SB(); fft_p2_mfma<true>(sm, tv); SYNC_SB();
            fft_i1<false, G2Raw>(sm, wB, [&](int l) -> G2Raw { G2Raw q; q.p0 = ldwin(r2 + t0, l); q.p1 = ldwin(r2 + t0 + SEQ, l); q.z0 = r3[t0 + l]; q.z1 = r3[t0 + SEQ + l]; return q; },
                [&](G2Raw v, int l) -> float2 { return make_float2(sconv_w(v.p0, l, c0, c1, c2, cb) * silu(bf2f(v.z0)), sconv_w(v.p1, l, c0, c1, c2, cb) * silu(bf2f(v.z1))); },
                [&](int l, float2 v) { grow[t0 + l] = f2bf(v.x); grow[t0 + SEQ + l] = f2bf(v.y); });
        }
    }
}

template <int HW> __device__ __forceinline__ void pool_rows(const bf16_t* __restrict__ us, bf16_t* __restrict__ pa, int cp, int th, int l0) {
    const bf16_t* col = us + 2 * cp;
    const int tb = th * 32;
    float s0 = 0.f, s1 = 0.f; int cnt = 0;
#pragma unroll
    for (int k = 0; k < 2 * HW; ++k) {
        const int q = l0 + tb - HW + k; const bool ok = (q >= 0) && (q < SEQ);
        const unsigned v = *(const unsigned*)(col + (tb + 8 - HW + k) * 512);
        s0 += ok ? __uint_as_float(v << 16) : 0.f; s1 += ok ? __uint_as_float(v & 0xffff0000u) : 0.f; cnt += ok ? 1 : 0;
    }
#pragma unroll 4
    for (int tt = 0; tt < 32; ++tt) {
        const int t = tb + tt, l = l0 + t;
        const unsigned cv = *(const unsigned*)(col + (t + 8) * 512);
        const float inv = 1.0f / (float)cnt;
        *(unsigned*)(pa + t * 520 + 2 * cp) = cvt_pk_bf16(s0 * inv - __uint_as_float(cv << 16), s1 * inv - __uint_as_float(cv & 0xffff0000u));
        if (tt < 31) {
            const unsigned va = *(const unsigned*)(col + (t + 8 + HW) * 512), vd = *(const unsigned*)(col + (t + 8 - HW) * 512);
            const bool oka = (l + HW) < SEQ, okd = (l - HW) >= 0;
            s0 += (oka ? __uint_as_float(va << 16) : 0.f) - (okd ? __uint_as_float(vd << 16) : 0.f);
            s1 += (oka ? __uint_as_float(va & 0xffff0000u) : 0.f) - (okd ? __uint_as_float(vd & 0xffff0000u) : 0.f);
            cnt += (oka ? 1 : 0) - (okd ? 1 : 0);
        }
    }
}

__device__ __forceinline__ void ph_mix(const Params& p, unsigned char* smem) {
    bf16_t* gs = (bf16_t*)smem;
    bf16_t* pa = (bf16_t*)smem;
    bf16_t* us = (bf16_t*)(smem + 67584);
    float* part = (float*)(smem + 67584 + 81920);
    float* rs = part + 512;
    const bf16_t* gT = (const bf16_t*)(p.ws + WS_GT);
    const bf16_t* pR = (const bf16_t*)(p.ws + WS_PR);
    const bf16_t* PWt = (const bf16_t*)(p.ws + WS_PWT);
    bf16_t* A2 = (bf16_t*)(p.ws + WS_A2);
    const float* pscale = p.in[15]; const float* nhg = p.in[16]; const float* npg = p.in[17];
    const int tid = threadIdx.x, lane = tid & 63, wid = tid >> 6, fr = lane & 15, fq = lane >> 4;
    for (int tile = blockIdx.x; tile < NTOK / 64; tile += gridDim.x) {
        const int tok0 = tile * 64, batch = tok0 / SEQ, l0 = tok0 % SEQ;
        __syncthreads();
        {
            u32x4 gv[8], uv[10];
#pragma unroll
            for (int k = 0; k < 8; ++k) { const int i = tid + k * NTHREADS, c = i >> 3, ch = i & 7; gv[k] = *(const u32x4*)(gT + (size_t)c * NTOK + tok0 + ch * 8); }
#pragma unroll
            for (int k = 0; k < 10; ++k) {
                const int i = tid + k * NTHREADS, r = i >> 6, ch = i & 63; int l = l0 - 8 + r; l = l < 0 ? 0 : (l > SEQ - 1 ? SEQ - 1 : l);
                uv[k] = *(const u32x4*)(pR + (size_t)(batch * SEQ + l) * 1024 + ch * 8);
            }
#pragma unroll
            for (int k = 0; k < 8; ++k) { const int i = tid + k * NTHREADS, c = i >> 3, ch = i & 7; unsigned* d = (unsigned*)(gs + c * 66 + ch * 8); d[0] = gv[k].x; d[1] = gv[k].y; d[2] = gv[k].z; d[3] = gv[k].w; }
#pragma unroll
            for (int k = 0; k < 10; ++k) { const int i = tid + k * NTHREADS, r = i >> 6, ch = i & 63; *(u32x4*)(us + r * 512 + ch * 8) = uv[k]; }
        }
        __syncthreads();
        {
            const int tok = tid & 63, cgp = tid >> 6; float s = 0.f;
#pragma unroll 16
            for (int cc = 0; cc < 64; ++cc) { const float v = bf2f(gs[(cgp * 64 + cc) * 66 + tok]); s += v * v; }
            part[cgp * 64 + tok] = s;
        }
        __syncthreads();
        if (tid < 64) { float s = 0.f; for (int g = 0; g < 8; ++g) s += part[g * 64 + tid]; rs[tid] = rsqrtf(s * (1.0f / 512.0f) + 1e-6f); }
        __syncthreads();
        {
            const int tok = wid * 8 + (lane >> 3), cseg = lane & 7; const float r = rs[tok];
#pragma unroll
            for (int j = 0; j < 8; ++j) {
                const int c0 = (cseg + 8 * j) * 8;
                const f32x4 ga = *(const f32x4*)(nhg + c0), gb = *(const f32x4*)(nhg + c0 + 4);
                float v[8];
#pragma unroll
                for (int i = 0; i < 8; ++i) v[i] = bf2f(gs[(c0 + i) * 66 + tok]) * r;
                u32x4 w; w.x = cvt_pk_bf16(v[0] * ga[0], v[1] * ga[1]); w.y = cvt_pk_bf16(v[2] * ga[2], v[3] * ga[3]); w.z = cvt_pk_bf16(v[4] * gb[0], v[5] * gb[1]); w.w = cvt_pk_bf16(v[6] * gb[2], v[7] * gb[3]);
                *(u32x4*)(A2 + (size_t)(tok0 + tok) * 1024 + c0) = w;
            }
        }
        __syncthreads();
        {
            const int cp = tid & 255, th = tid >> 8, g = cp >> 6;
            if (g == 0) pool_rows<1>(us, pa, cp, th, l0);
            else if (g == 1) pool_rows<2>(us, pa, cp, th, l0);
            else if (g == 2) pool_rows<4>(us, pa, cp, th, l0);
            else pool_rows<8>(us, pa, cp, th, l0);
        }
        __syncthreads();
        {
            const int g = wid >> 1, nh = wid & 1;
            f32x4 acc[4][4];
#pragma unroll
            for (int m = 0; m < 4; ++m)
#pragma unroll
                for (int n = 0; n < 4; ++n) acc[m][n] = (f32x4){0.f, 0.f, 0.f, 0.f};
#pragma unroll
            for (int kk = 0; kk < 4; ++kk) {
                bf16x8 Af[4], Bf[4];
#pragma unroll
                for (int m = 0; m < 4; ++m) Af[m] = *(const bf16x8*)(pa + (16 * m + fr) * 520 + g * 128 + kk * 32 + fq * 8);
#pragma unroll
                for (int n = 0; n < 4; ++n) Bf[n] = *(const bf16x8*)(PWt + g * 16384 + (nh * 64 + 16 * (fr >> 2) + 4 * n + (fr & 3)) * 128 + kk * 32 + fq * 8);
#pragma unroll
                for (int m = 0; m < 4; ++m)
#pragma unroll
                    for (int n = 0; n < 4; ++n) acc[m][n] = __builtin_amdgcn_mfma_f32_16x16x32_bf16(Bf[n], Af[m], acc[m][n], 0, 0, 0);
            }
            float ssq[4];
#pragma unroll
            for (int m = 0; m < 4; ++m) {
                const int t = 16 * m + fr; float s = 0.f;
                const int dbase = g * 128 + nh * 64 + 16 * fq;
                const u32x4 zq0 = *(const u32x4*)(pR + (size_t)(tok0 + t) * 1024 + 512 + dbase), zq1 = *(const u32x4*)(pR + (size_t)(tok0 + t) * 1024 + 512 + dbase + 8);
#pragma unroll
                for (int n = 0; n < 4; ++n) {
                    const int dch = dbase + 4 * n;
                    uint2 zz; zz.x = (n < 2 ? zq0 : zq1)[2 * (n & 1)]; zz.y = (n < 2 ? zq0 : zq1)[2 * (n & 1) + 1];
                    const f32x4 ps = *(const f32x4*)(pscale + dch);
                    const float z0 = __uint_as_float(zz.x << 16), z1 = __uint_as_float(zz.x & 0xffff0000u), z2 = __uint_as_float(zz.y << 16), z3 = __uint_as_float(zz.y & 0xffff0000u);
                    f32x4 v = acc[m][n];
                    v[0] = v[0] * ps[0] * silu(z0); v[1] = v[1] * ps[1] * silu(z1); v[2] = v[2] * ps[2] * silu(z2); v[3] = v[3] * ps[3] * silu(z3);
                    acc[m][n] = v;
                    s += v[0] * v[0] + v[1] * v[1] + v[2] * v[2] + v[3] * v[3];
                }
                s += __shfl_xor(s, 16); s += __shfl_xor(s, 32);
                ssq[m] = s;
            }
            if (fq == 0) {
#pragma unroll
                for (int m = 0; m < 4; ++m) part[wid * 64 + 16 * m + fr] = ssq[m];
            }
            __syncthreads();
            if (tid < 64) { float s = 0.f; for (int w = 0; w < 8; ++w) s += part[w * 64 + tid]; rs[tid] = rsqrtf(s * (1.0f / 512.0f) + 1e-6f); }
            __syncthreads();
#pragma unroll
            for (int m = 0; m < 4; ++m) {
                const int t = 16 * m + fr; const float r = rs[t];
                const int dbase = g * 128 + nh * 64 + 16 * fq;
                unsigned wv[8];
#pragma unroll
                for (int n = 0; n < 4; ++n) {
                    const f32x4 ng = *(const f32x4*)(npg + dbase + 4 * n);
                    const f32x4 v = acc[m][n];
                    wv[2 * n] = cvt_pk_bf16(v[0] * r * ng[0], v[1] * r * ng[1]); wv[2 * n + 1] = cvt_pk_bf16(v[2] * r * ng[2], v[3] * r * ng[3]);
                }
                *(u32x4*)(A2 + (size_t)(tok0 + t) * 1024 + 512 + dbase) = (u32x4){wv[0], wv[1], wv[2], wv[3]};
                *(u32x4*)(A2 + (size_t)(tok0 + t) * 1024 + 512 + dbase + 8) = (u32x4){wv[4], wv[5], wv[6], wv[7]};
            }
        }
    }
}

__device__ __forceinline__ void ph_final(const Params& p) {
    const float* __restrict__ x = p.in[0]; const float* __restrict__ pg = p.in[19];
    const bf16_t* __restrict__ ob = (const bf16_t*)(p.ws + WS_OUTB);
    float* __restrict__ out = p.out;
    const int lane = threadIdx.x & 63, wid = threadIdx.x >> 6;
    float4 g4[4];
#pragma unroll
    for (int h = 0; h < 2; ++h) { g4[2 * h] = ((const float4*)pg)[128 * h + lane * 2]; g4[2 * h + 1] = ((const float4*)pg)[128 * h + lane * 2 + 1]; }
    for (int row = blockIdx.x * 8 + wid; row < NTOK; row += gridDim.x * 8) {
        const float4* xr = (const float4*)(x + (size_t)row * DM);
        float4 xv[4]; u32x4 ov[2];
#pragma unroll
        for (int h = 0; h < 2; ++h) { ov[h] = *(const u32x4*)(ob + (size_t)row * DM + 512 * h + lane * 8); xv[2 * h] = xr[128 * h + lane * 2]; xv[2 * h + 1] = xr[128 * h + lane * 2 + 1]; }
        float o[16]; float ss = 0.f;
#pragma unroll
        for (int h = 0; h < 2; ++h)
#pragma unroll
            for (int e = 0; e < 4; ++e) { const unsigned w = ov[h][e]; o[h * 8 + 2 * e] = __uint_as_float(w << 16); o[h * 8 + 2 * e + 1] = __uint_as_float(w & 0xffff0000u); }
#pragma unroll
        for (int e = 0; e < 16; ++e) ss += o[e] * o[e];
        ss = wave_sum(ss);
        const float r = rsqrtf(ss * (1.0f / DM) + 1e-6f);
#pragma unroll
        for (int q = 0; q < 4; ++q) {
            float4 y;
            y.x = xv[q].x + o[q * 4 + 0] * r * g4[q].x; y.y = xv[q].y + o[q * 4 + 1] * r * g4[q].y; y.z = xv[q].z + o[q * 4 + 2] * r * g4[q].z; y.w = xv[q].w + o[q * 4 + 3] * r * g4[q].w;
            ((float4*)(out + (size_t)row * DM))[128 * (q >> 1) + lane * 2 + (q & 1)] = y;
        }
    }
}

#define XB_TMO      128
#define XB_XCNT(j)  (256  + 64 * (j))
#define XB_XSUB(j)  (1280 + 64 * (j))
#define XB_XGEN(j)  (2304 + 64 * (j))
#define XB_TOP      3328
#define XB_TOPGEN   3392
#define XCD_BAR_WORDS 3456
#define XB_SPIN_CAP (1u << 18)
#define LAS __attribute__((address_space(3)))

__device__ __forceinline__ unsigned xb_ld(unsigned* p)              { return __hip_atomic_load(p, __ATOMIC_RELAXED, __HIP_MEMORY_SCOPE_AGENT); }
__device__ __forceinline__ unsigned xb_add(unsigned* p, unsigned v) { return __hip_atomic_fetch_add(p, v, __ATOMIC_RELAXED, __HIP_MEMORY_SCOPE_AGENT); }
__device__ __forceinline__ unsigned xb_xcc_id() { return (unsigned)__builtin_amdgcn_s_getreg((3 << 11) | 20) & 0xFu; }
#define XB_SPIN(cond, bar) do { unsigned _sp = 0; while (cond) { __builtin_amdgcn_s_sleep(1); \
    if ((++_sp & 255u) == 0u) { if (xb_ld(&(bar)[XB_TMO])) break; if (_sp > XB_SPIN_CAP) { atomicAdd(&(bar)[XB_TMO], 1u); break; } } } } while (0)

struct XcdBarrier {
    unsigned* bar; unsigned x;
    volatile LAS unsigned* st;
};

__device__ __forceinline__ XcdBarrier xcd_barrier_post(unsigned* bar, volatile LAS unsigned* st) {
    XcdBarrier b; b.bar = bar; b.x = xb_xcc_id(); b.st = st;
    if (threadIdx.x == 0) (void)xb_add(&bar[XB_XCNT(b.x)], 1u);
    return b;
}
__device__ __forceinline__ void xcd_barrier_complete(unsigned* bar, unsigned x, unsigned& nloc, unsigned& nx) {
    const unsigned G = gridDim.x * gridDim.y * gridDim.z;
    unsigned sum, cnt, mine, sp = 0u;
    for (;;) {
        sum = 0u; cnt = 0u; mine = 0u;
#pragma unroll
        for (unsigned j = 0; j < 16; ++j) { const unsigned c = xb_ld(&bar[XB_XCNT(j)]); sum += c; cnt += (c > 0u) ? 1u : 0u; mine = (j == x) ? c : mine; }
        if (sum == G) break;
        __builtin_amdgcn_s_sleep(1);
        if ((++sp & 255u) == 0u) { if (xb_ld(&bar[XB_TMO])) break; if (sp > XB_SPIN_CAP) { atomicAdd(&bar[XB_TMO], 1u); break; } }
    }
    nloc = mine > 0u ? mine : 1u; nx = cnt > 0u ? cnt : 1u;
}

__device__ __forceinline__ void xcd_barrier(const XcdBarrier& b) {
    asm volatile("s_waitcnt vmcnt(0)" ::: "memory");
    __syncthreads();
    if (threadIdx.x == 0) {
        unsigned* bar = b.bar;
        __builtin_amdgcn_s_waitcnt(0);
        unsigned nloc = b.st[0], nx = b.st[1];
        if (nloc == 0u) { xcd_barrier_complete(bar, b.x, nloc, nx); b.st[0] = nloc; b.st[1] = nx; }
        const unsigned old = xb_add(&bar[XB_XSUB(b.x)], 1u);
        const unsigned gen = old / nloc;
        if (old + 1u == (gen + 1u) * nloc) {
            __builtin_amdgcn_fence(__ATOMIC_RELEASE, "agent");
            asm volatile("s_waitcnt vmcnt(0)" ::: "memory");
            const unsigned og = xb_add(&bar[XB_TOP], 1u);
            const unsigned tg = og / nx;
            if (og + 1u == (tg + 1u) * nx) xb_add(&bar[XB_TOPGEN], 1u);
            else XB_SPIN(xb_ld(&bar[XB_TOPGEN]) == tg, bar);
            __builtin_amdgcn_fence(__ATOMIC_ACQUIRE, "agent");
            xb_add(&bar[XB_XGEN(b.x)], 1u);
            asm volatile("s_waitcnt vmcnt(0)" ::: "memory");
        } else {
            XB_SPIN(xb_ld(&bar[XB_XGEN(b.x)]) == gen, bar);
            __builtin_amdgcn_fence(__ATOMIC_ACQUIRE, "agent");
            asm volatile("s_waitcnt vmcnt(0)" ::: "memory");
        }
    }
    __syncthreads();
}


__global__ void __launch_bounds__(512, 2) hyena_fwd(Params p) {
    extern __shared__ __attribute__((aligned(16))) unsigned char smem[];
    cg::grid_group grid = cg::this_grid();
    __shared__ uint4 xb_words;
    if (threadIdx.x == 0) xb_words = make_uint4(0u, 0u, 0u, 0u);
    __syncthreads();
    const bool coop = (p.phase_hi - p.phase_lo) > 1;
    XcdBarrier xb; xb.bar = (unsigned*)(p.ws + WS_BAR); xb.x = 0; xb.st = (volatile LAS unsigned*)&xb_words;
    if (coop) xb = xcd_barrier_post((unsigned*)(p.ws + WS_BAR), (volatile LAS unsigned*)&xb_words);
    if (p.phase_hi > 1000) grid.sync();
#ifndef REP_PH
#define REP_PH -1
#endif
#define PH_ON(i) (p.phase_lo <= (i) && (i) < p.phase_hi)
#define PH_REP(i) for (int rep_ = 0; rep_ < ((i) == REP_PH ? 2 : 1); ++rep_)
#define PH_SYNC(i) do { if (PH_ON(i) && (i) + 1 < p.phase_hi) xcd_barrier(xb); } while (0)
    if (PH_ON(0)) PH_REP(0) {
        const int nmem = (gridDim.x + 1) / 2, ncmp = gridDim.x - nmem;
        if (gridDim.x < 2) { ph_weights(p, 0, 1); ph_rmsnorm_in(p.in[0], (bf16_t*)(p.ws + WS_XN), 0, 1); ph_filters(p, (float*)smem, 0, 1); }
        else if ((blockIdx.x & 1) == 0) { ph_weights(p, blockIdx.x >> 1, nmem); ph_rmsnorm_in(p.in[0], (bf16_t*)(p.ws + WS_XN), blockIdx.x >> 1, nmem); }
        else ph_filters(p, (float*)smem, blockIdx.x >> 1, ncmp);
    }
    PH_SYNC(0);
    if (PH_ON(1)) PH_REP(1) {
        pg8::StaticOrder S;
        { pg8::Gemm g{(const bf16_t*)(p.ws + WS_W1T), (const bf16_t*)(p.ws + WS_XN), 2048, NTOK, 1024};
          pg8::EpiBf16<0> E{(bf16_t*)(p.ws + WS_PT), NTOK, nullptr, 0, 0};
          S.init(g.M, g.N, gridDim.x, blockIdx.x);
          pg8::gemm_phase<pg8::EpiBf16<0>, pg8::StaticOrder, false>((PG8_LAS unsigned char*)smem, g, S, E, nullptr); }
        __syncthreads();
        { pg8::Gemm g{(const bf16_t*)(p.ws + WS_XN), (const bf16_t*)(p.ws + WS_W1T) + (size_t)2048 * 1024, NTOK, 1024, 1024};
          pg8::EpiBf16<0> E{(bf16_t*)(p.ws + WS_PR), 1024, nullptr, 0, 0};
          S.init(g.M, g.N, gridDim.x, blockIdx.x);
          pg8::gemm_phase<pg8::EpiBf16<0>, pg8::StaticOrder, false>((PG8_LAS unsigned char*)smem, g, S, E, nullptr); }
    }
    PH_SYNC(1);
    if (PH_ON(2)) PH_REP(2) ph_fftconv(p, (float2*)smem);
    PH_SYNC(2);
    if (PH_ON(3)) PH_REP(3) ph_mix(p, smem);
    PH_SYNC(3);
    if (PH_ON(4)) PH_REP(4) {
        pg8::StaticOrder S;
        pg8::Gemm g{(const bf16_t*)(p.ws + WS_A2), (const bf16_t*)(p.ws + WS_W2T), NTOK, 1024, 1024};
        pg8::EpiBf16<0> E{(bf16_t*)(p.ws + WS_OUTB), 1024, nullptr, 0, 0};
        S.init(g.M, g.N, gridDim.x, blockIdx.x);
        pg8::gemm_phase<pg8::EpiBf16<0>, pg8::StaticOrder, false>((PG8_LAS unsigned char*)smem, g, S, E, nullptr);
    }
    PH_SYNC(4);
    if (PH_ON(5)) PH_REP(5) ph_final(p);
}

#ifndef COOP
#define COOP 1
#endif
extern "C" void kernel_launch(void* const* d_in, const int* in_sizes, int n_in, void* d_out, int out_size, void* d_ws, size_t ws_size, hipStream_t stream) {
    static int grid_blocks = 0;
    if (!grid_blocks) {
        int dev = 0, cus = 0, per_cu = 0;
        (void)hipGetDevice(&dev);
        (void)hipDeviceGetAttribute(&cus, hipDeviceAttributeMultiprocessorCount, dev);
        (void)hipFuncSetAttribute((const void*)hyena_fwd, hipFuncAttributeMaxDynamicSharedMemorySize, LDS_BYTES);
        (void)hipOccupancyMaxActiveBlocksPerMultiprocessor(&per_cu, (const void*)hyena_fwd, NTHREADS, LDS_BYTES);
        if (per_cu < 1) { fprintf(stderr, "occupancy query says %d blocks/CU\n", per_cu); per_cu = 1; }
        grid_blocks = cus * 1;
        (void)hipGetLastError();
    }
    Params p{};
    for (int i = 0; i < 20; ++i) p.in[i] = (const float*)d_in[i];
    p.out = (float*)d_out; p.ws = (unsigned char*)d_ws;
#if COOP
    (void)hipMemsetAsync((unsigned char*)d_ws + WS_BAR, 0, XCD_BAR_WORDS * sizeof(unsigned), stream);
    p.phase_lo = 0; p.phase_hi = NPHASE;
    void* args[] = {&p};
    hipError_t e = hipLaunchCooperativeKernel((const void*)hyena_fwd, dim3(grid_blocks), dim3(NTHREADS), args, LDS_BYTES, stream);
    if (e != hipSuccess) fprintf(stderr, "cooperative launch failed: %s (grid %d)\n", hipGetErrorString(e), grid_blocks);
#else
    for (int ph = 0; ph < NPHASE; ++ph) {
        p.phase_lo = ph; p.phase_hi = ph + 1;
        hipLaunchKernelGGL(hyena_fwd, dim3(grid_blocks), dim3(NTHREADS), LDS_BYTES, stream, p);
    }
#endif
}
```
